# Optimizing an MI355X kernel written in HIP

```python
import math
import jax, jax.numpy as jnp
from jax import lax
import numpy as np

D_MODEL = 1024
BATCH = 2
SEQ = 16384
DEPTH = 2

N_EVEN = (DEPTH + 1) // 2
N_ODD = DEPTH // 2

MEM_LEN = 256
NORM_EPS = 1e-6

MLA_HEADS = 8
MLA_NOPE = 64
MLA_ROPE = 32
MLA_QK = MLA_NOPE + MLA_ROPE
MLA_V = 64
MLA_Q_RANK = 384
MLA_KV_RANK = 256
ROPE_BASE = 10000.0
Q_BLOCK = 128

RW_HEADS = 8
RW_HEAD = 64
RW_DIM = RW_HEADS * RW_HEAD
RW_DECAY_LORA = 64
RW_AAA_LORA = 64
RW_GATE_LORA = 128
RW_LN_EPS = 64e-5

MLA_IN = MLA_Q_RANK + MLA_KV_RANK + MLA_ROPE
RW_IN = 3 * RW_DIM + RW_DECAY_LORA + RW_AAA_LORA + RW_GATE_LORA
EVEN_IN = MLA_IN + RW_IN
EVEN_MIX = MLA_HEADS * MLA_V + RW_DIM

SSM_INNER = 2 * D_MODEL
SSM_HEAD = 64
SSM_HEADS = SSM_INNER // SSM_HEAD
SSM_GROUPS = 4
SSM_STATE = 128
SSM_CONV = 4
SSM_CHUNK = 256
SSM_CONV_DIM = SSM_INNER + 2 * SSM_GROUPS * SSM_STATE
ODD_IN = SSM_INNER + SSM_CONV_DIM + SSM_HEADS

X_HEADS = 4
X_HEAD = 128
X_DIM = X_HEADS * X_HEAD

FFN_HIDDEN = -((-8 * D_MODEL) // (3 * 256)) * 256

kernel_name = "hybrid_mla_rwkv7_mamba2_memxattn"


def rms_norm(x, g, eps=NORM_EPS):
    xf = x.astype(jnp.float32)
    y = xf * lax.rsqrt(jnp.mean(xf * xf, axis=-1, keepdims=True) + eps)
    return (y * g.astype(jnp.float32)).astype(x.dtype)


def apply_rope(x, positions):
    half = x.shape[-1] // 2
    inv_freq = ROPE_BASE ** (-jnp.arange(half, dtype=jnp.float32) / half)
    ang = positions.astype(jnp.float32)[:, :, None, None] * inv_freq
    cos, sin = jnp.cos(ang), jnp.sin(ang)
    xf = x.astype(jnp.float32)
    x1, x2 = xf[..., :half], xf[..., half:]
    return jnp.concatenate([x1 * cos - x2 * sin, x2 * cos + x1 * sin], axis=-1).astype(x.dtype)


def causal_block_attention(q, k, v):
    b, s, h, dk = q.shape
    nb = s // Q_BLOCK
    scale = dk ** -0.5
    qb = jnp.moveaxis(q.reshape(b, nb, Q_BLOCK, h, dk), 1, 0)
    k_idx = jnp.arange(s)

    def block(args):
        q_blk, blk = args
        scores = jnp.einsum("bqhd,bkhd->bhqk", q_blk, k, preferred_element_type=jnp.float32) * scale
        q_idx = blk * Q_BLOCK + jnp.arange(Q_BLOCK)
        scores = jnp.where(k_idx[None, :] <= q_idx[:, None], scores, -jnp.inf)
        probs = jax.nn.softmax(scores, axis=-1).astype(v.dtype)
        return jnp.einsum("bhqk,bkhd->bqhd", probs, v)

    out = lax.map(block, (qb, jnp.arange(nb)))
    return jnp.moveaxis(out, 0, 1).reshape(b, s, h, v.shape[-1])


def mla_group(p, positions, q_norm, w_uq, kv_norm, w_ukv, q_hnorm, k_hnorm):
    b, s, _ = p.shape
    c_q = rms_norm(p[..., :MLA_Q_RANK], q_norm)
    c_kv = rms_norm(p[..., MLA_Q_RANK:MLA_Q_RANK + MLA_KV_RANK], kv_norm)
    k_rope = p[..., MLA_Q_RANK + MLA_KV_RANK:]
    q = (c_q @ w_uq).reshape(b, s, MLA_HEADS, MLA_QK)
    kv = (c_kv @ w_ukv).reshape(b, s, MLA_HEADS, MLA_NOPE + MLA_V)
    k_nope, v = kv[..., :MLA_NOPE], kv[..., MLA_NOPE:]
    k = jnp.concatenate([k_nope, jnp.broadcast_to(k_rope[:, :, None, :], (b, s, MLA_HEADS, MLA_ROPE))], axis=-1)
    q = rms_norm(q, q_hnorm)
    k = rms_norm(k, k_hnorm)
    q = jnp.concatenate([q[..., :MLA_NOPE], apply_rope(q[..., MLA_NOPE:], positions)], axis=-1)
    k = jnp.concatenate([k[..., :MLA_NOPE], apply_rope(k[..., MLA_NOPE:], positions)], axis=-1)
    return causal_block_attention(q, k, v).reshape(b, s, MLA_HEADS * MLA_V)


def token_shift(p, mu):
    prev = jnp.pad(p, ((0, 0), (1, 0), (0, 0)))[:, :-1]
    return p + (prev - p) * mu


def wkv7_scan(r, w, k, v, a, bb):
    b, s, h, n = r.shape
    xs = tuple(jnp.moveaxis(t.astype(jnp.float32), 1, 0) for t in (r, w, k, v, a, bb))

    def step(state, inp):
        r_t, w_t, k_t, v_t, a_t, b_t = inp
        sa = jnp.einsum("bhvk,bhk->bhv", state, a_t)
        state = state * w_t[:, :, None, :] + sa[..., None] * b_t[:, :, None, :] + v_t[..., None] * k_t[:, :, None, :]
        return state, jnp.einsum("bhvk,bhk->bhv", state, r_t)

    state0 = jnp.zeros((b, h, n, n), jnp.float32)
    _, ys = lax.scan(step, state0, xs)
    return jnp.moveaxis(ys, 0, 1)


def rwkv7_group(p, mu, w0, w2, a0, a2, g2, k_k, k_a, r_k, ln_g, ln_b):
    b, s, _ = p.shape
    p = token_shift(p, mu)
    r = p[..., :RW_DIM]
    k = p[..., RW_DIM:2 * RW_DIM]
    v = p[..., 2 * RW_DIM:3 * RW_DIM]
    o = 3 * RW_DIM
    xw = p[..., o:o + RW_DECAY_LORA]
    o += RW_DECAY_LORA
    xa = p[..., o:o + RW_AAA_LORA]
    o += RW_AAA_LORA
    xg = p[..., o:o + RW_GATE_LORA]
    w_log = -jax.nn.softplus(-(w0 + jnp.tanh(xw) @ w2)) - 0.5
    decay = jnp.exp(-jnp.exp(w_log.astype(jnp.float32)))
    a = jax.nn.sigmoid(a0 + xa @ a2)
    g = jax.nn.sigmoid(xg) @ g2
    heads = lambda t: t.reshape(b, s, RW_HEADS, RW_HEAD)
    kk = heads(k * k_k).astype(jnp.float32)
    kk = kk / jnp.maximum(jnp.sqrt(jnp.sum(kk * kk, axis=-1, keepdims=True)), 1e-12)
    k = k * (1.0 + (a - 1.0) * k_a)
    r_h, k_h, v_h, a_h = heads(r), heads(k), heads(v), heads(a).astype(jnp.float32)
    y = wkv7_scan(r_h, heads(decay), k_h, v_h, -kk, kk * a_h)
    mean = jnp.mean(y, axis=-1, keepdims=True)
    var = jnp.mean(jnp.square(y - mean), axis=-1, keepdims=True)
    y = ((y - mean) * lax.rsqrt(var + RW_LN_EPS)).reshape(b, s, RW_DIM)
    y = (y * ln_g.astype(jnp.float32) + ln_b.astype(jnp.float32)).astype(p.dtype)
    bonus = jnp.sum(r_h * k_h * r_k, axis=-1, keepdims=True) * v_h
    y = y + bonus.reshape(b, s, RW_DIM)
    return y * g


def even_mixer(h, positions, norm, w_in, q_norm, w_uq, kv_norm, w_ukv, q_hnorm, k_hnorm,
               mu, w0, w2, a0, a2, g2, k_k, k_a, r_k, ln_g, ln_b, w_out):
    proj = rms_norm(h, norm) @ w_in
    y_mla = mla_group(proj[..., :MLA_IN], positions, q_norm, w_uq, kv_norm, w_ukv, q_hnorm, k_hnorm)
    y_rw = rwkv7_group(proj[..., MLA_IN:], mu, w0, w2, a0, a2, g2, k_k, k_a, r_k, ln_g, ln_b)
    return jnp.concatenate([y_mla, y_rw], axis=-1) @ w_out


def causal_depthwise_conv(x, w, bias):
    width, c = w.shape
    out = lax.conv_general_dilated(x, w[:, None, :].astype(x.dtype), window_strides=(1,),
                                   padding=((width - 1, 0),),
                                   dimension_numbers=("NWC", "WIO", "NWC"),
                                   feature_group_count=c)
    return out + bias


def ssd_chunked(x, a, b_in, c_in):
    bsz, s, n_heads, head_p = x.shape
    n_groups, n_state = b_in.shape[2], b_in.shape[3]
    e_per = n_heads // n_groups
    L = SSM_CHUNK
    nc = -(-s // L)
    pad = nc * L - s
    padt = lambda t: jnp.pad(t.astype(jnp.float32), ((0, 0), (0, pad)) + ((0, 0),) * (t.ndim - 2))
    xc = padt(x).reshape(bsz, nc, L, n_groups, e_per, head_p)
    ac = padt(a).reshape(bsz, nc, L, n_groups, e_per)
    bc = padt(b_in).reshape(bsz, nc, L, n_groups, n_state)
    cc = padt(c_in).reshape(bsz, nc, L, n_groups, n_state)
    xs = tuple(jnp.moveaxis(t, 1, 0) for t in (xc, ac, bc, cc))
    causal = jnp.tril(jnp.ones((L, L), dtype=bool))[None, :, :, None, None]

    def step(state, inp):
        x_c, a_c, b_c, c_c = inp
        cum = jnp.cumsum(a_c, axis=1)
        seg = cum[:, :, None] - cum[:, None, :]
        decay = jnp.exp(jnp.where(causal, seg, -jnp.inf))
        cb = jnp.einsum("blgn,bsgn->blsg", c_c, b_c)
        y = jnp.einsum("blsg,blsge,bsgep->blgep", cb, decay, x_c)
        y = y + jnp.einsum("blgn,bgepn->blgep", c_c, state) * jnp.exp(cum)[..., None]
        to_end = jnp.exp(cum[:, -1:] - cum)
        state = state * jnp.exp(cum[:, -1])[..., None, None] + jnp.einsum("blgn,blge,blgep->bgepn", b_c, to_end, x_c)
        return state, y

    state0 = jnp.zeros((bsz, n_groups, e_per, head_p, n_state), jnp.float32)
    _, ys = lax.scan(step, state0, xs)
    return jnp.moveaxis(ys, 0, 1).reshape(bsz, nc * L, n_heads, head_p)[:, :s]


def mamba2_mixer(h, norm, w_in, conv_w, conv_b, dt_bias, a_log, d_skip, gnorm, w_out):
    b, s, _ = h.shape
    proj = rms_norm(h, norm) @ w_in
    z = proj[..., :SSM_INNER]
    xbc = proj[..., SSM_INNER:SSM_INNER + SSM_CONV_DIM]
    dt_raw = proj[..., SSM_INNER + SSM_CONV_DIM:]
    xbc = jax.nn.silu(causal_depthwise_conv(xbc, conv_w, conv_b))
    gn = SSM_GROUPS * SSM_STATE
    xs = xbc[..., :SSM_INNER].reshape(b, s, SSM_HEADS, SSM_HEAD)
    b_in = xbc[..., SSM_INNER:SSM_INNER + gn].reshape(b, s, SSM_GROUPS, SSM_STATE)
    c_in = xbc[..., SSM_INNER + gn:].reshape(b, s, SSM_GROUPS, SSM_STATE)
    dt = jax.nn.softplus(dt_raw.astype(jnp.float32) + dt_bias.astype(jnp.float32))
    A = -jnp.exp(a_log.astype(jnp.float32))
    xf = xs.astype(jnp.float32)
    y = ssd_chunked(xf * dt[..., None], dt * A, b_in, c_in)
    y = y + xf * d_skip.astype(jnp.float32)[:, None]
    y = y.reshape(b, s, SSM_INNER) * jax.nn.silu(z.astype(jnp.float32))
    y = y.reshape(b, s, SSM_GROUPS, SSM_INNER // SSM_GROUPS)
    y = y * lax.rsqrt(jnp.mean(y * y, axis=-1, keepdims=True) + NORM_EPS)
    y = (y.reshape(b, s, SSM_INNER) * gnorm.astype(jnp.float32)).astype(h.dtype)
    return y @ w_out


def memory_cross_attention(h, mem, norm_x, norm_mem, wq, wkv, q_hnorm, k_hnorm, wo):
    b, s, _ = h.shape
    m = mem.shape[1]
    q = (rms_norm(h, norm_x) @ wq).reshape(b, s, X_HEADS, X_HEAD)
    kv = (rms_norm(mem, norm_mem) @ wkv).reshape(b, m, 2, X_HEADS, X_HEAD)
    q = rms_norm(q, q_hnorm)
    k = rms_norm(kv[:, :, 0], k_hnorm)
    v = kv[:, :, 1]
    scores = jnp.einsum("bqhd,bmhd->bhqm", q, k, preferred_element_type=jnp.float32) * (X_HEAD ** -0.5)
    probs = jax.nn.softmax(scores, axis=-1).astype(v.dtype)
    out = jnp.einsum("bhqm,bmhd->bqhd", probs, v).reshape(b, s, X_DIM)
    return out @ wo


def swiglu_ffn(h, norm, w13, w2):
    u = rms_norm(h, norm) @ w13
    return (jax.nn.silu(u[..., :FFN_HIDDEN]) * u[..., FFN_HIDDEN:]) @ w2


def setup_inputs(seed: int = 0) -> dict:
    key = jax.random.key(seed)
    ks = iter(jax.random.split(key, 64))
    f32 = jnp.float32

    def nrm(shape, fan_in, scale=1.0):
        return scale * fan_in ** -0.5 * jax.random.normal(next(ks), shape, f32)

    def gain(shape):
        return 1.0 + 0.05 * jax.random.normal(next(ks), shape, f32)

    def unif(shape, lo, hi):
        return jax.random.uniform(next(ks), shape, f32, lo, hi)

    E, O, L = N_EVEN, N_ODD, DEPTH
    x = jax.random.normal(next(ks), (BATCH, SEQ, D_MODEL), f32)
    mem = jax.random.normal(next(ks), (BATCH, MEM_LEN, D_MODEL), f32)
    positions = (jax.random.randint(next(ks), (BATCH, 1), 0, 1024, jnp.int32)
                 + jnp.arange(SEQ, dtype=jnp.int32)[None, :])
    dt0 = jnp.exp(unif((O, SSM_HEADS), math.log(1e-3), math.log(1e-1)))
    return {
        "x": x, "mem": mem, "positions": positions,
        "ev_norm": gain((E, D_MODEL)),
        "ev_w_in": nrm((E, D_MODEL, EVEN_IN), D_MODEL),
        "mla_q_norm": gain((E, MLA_Q_RANK)),
        "mla_w_uq": nrm((E, MLA_Q_RANK, MLA_HEADS * MLA_QK), MLA_Q_RANK),
        "mla_kv_norm": gain((E, MLA_KV_RANK)),
        "mla_w_ukv": nrm((E, MLA_KV_RANK, MLA_HEADS * (MLA_NOPE + MLA_V)), MLA_KV_RANK),
        "mla_q_hnorm": gain((E, MLA_QK)),
        "mla_k_hnorm": gain((E, MLA_QK)),
        "rw_mu": unif((E, RW_IN), 0.0, 1.0),
        "rw_w0": unif((E, RW_DIM), -6.0, -1.0),
        "rw_w2": nrm((E, RW_DECAY_LORA, RW_DIM), RW_DECAY_LORA),
        "rw_a0": 0.1 * jax.random.normal(next(ks), (E, RW_DIM), f32),
        "rw_a2": nrm((E, RW_AAA_LORA, RW_DIM), RW_AAA_LORA),
        "rw_g2": nrm((E, RW_GATE_LORA, RW_DIM), RW_GATE_LORA),
        "rw_k_k": unif((E, RW_DIM), 0.7, 1.0),
        "rw_k_a": unif((E, RW_DIM), 0.8, 1.2),
        "rw_r_k": 0.1 * jax.random.normal(next(ks), (E, RW_HEADS, RW_HEAD), f32),
        "rw_ln_g": gain((E, RW_DIM)),
        "rw_ln_b": 0.02 * jax.random.normal(next(ks), (E, RW_DIM), f32),
        "ev_w_out": nrm((E, EVEN_MIX, D_MODEL), EVEN_MIX),
        "od_norm": gain((O, D_MODEL)),
        "od_w_in": nrm((O, D_MODEL, ODD_IN), D_MODEL),
        "ssm_conv_w": nrm((O, SSM_CONV, SSM_CONV_DIM), SSM_CONV),
        "ssm_conv_b": 0.02 * jax.random.normal(next(ks), (O, SSM_CONV_DIM), f32),
        "ssm_dt_bias": dt0 + jnp.log(-jnp.expm1(-dt0)),
        "ssm_a_log": jnp.log(unif((O, SSM_HEADS), 1.0, 16.0)),
        "ssm_d": gain((O, SSM_HEADS)),
        "ssm_gnorm": gain((O, SSM_INNER)),
        "od_w_out": nrm((O, SSM_INNER, D_MODEL), SSM_INNER),
        "xa_norm_x": gain((L, D_MODEL)),
        "xa_norm_mem": gain((L, D_MODEL)),
        "xa_wq": nrm((L, D_MODEL, X_DIM), D_MODEL),
        "xa_wkv": nrm((L, D_MODEL, 2 * X_DIM), D_MODEL),
        "xa_q_hnorm": gain((L, X_HEAD)),
        "xa_k_hnorm": gain((L, X_HEAD)),
        "xa_wo": nrm((L, X_DIM, D_MODEL), X_DIM),
        "ffn_norm": gain((L, D_MODEL)),
        "ffn_w13": nrm((L, D_MODEL, 2 * FFN_HIDDEN), D_MODEL),
        "ffn_w2": nrm((L, FFN_HIDDEN, D_MODEL), FFN_HIDDEN),
    }


def reference(x, mem, positions,
              ev_norm, ev_w_in, mla_q_norm, mla_w_uq, mla_kv_norm, mla_w_ukv, mla_q_hnorm, mla_k_hnorm,
              rw_mu, rw_w0, rw_w2, rw_a0, rw_a2, rw_g2, rw_k_k, rw_k_a, rw_r_k, rw_ln_g, rw_ln_b, ev_w_out,
              od_norm, od_w_in, ssm_conv_w, ssm_conv_b, ssm_dt_bias, ssm_a_log, ssm_d, ssm_gnorm, od_w_out,
              xa_norm_x, xa_norm_mem, xa_wq, xa_wkv, xa_q_hnorm, xa_k_hnorm, xa_wo,
              ffn_norm, ffn_w13, ffn_w2):
    h = x
    for i in range(DEPTH):
        j = i // 2
        if i % 2 == 0:
            h = h + even_mixer(h, positions, ev_norm[j], ev_w_in[j], mla_q_norm[j], mla_w_uq[j],
                               mla_kv_norm[j], mla_w_ukv[j], mla_q_hnorm[j], mla_k_hnorm[j],
                               rw_mu[j], rw_w0[j], rw_w2[j], rw_a0[j], rw_a2[j], rw_g2[j],
                               rw_k_k[j], rw_k_a[j], rw_r_k[j], rw_ln_g[j], rw_ln_b[j], ev_w_out[j])
        else:
            h = h + mamba2_mixer(h, od_norm[j], od_w_in[j], ssm_conv_w[j], ssm_conv_b[j],
                                 ssm_dt_bias[j], ssm_a_log[j], ssm_d[j], ssm_gnorm[j], od_w_out[j])
        h = h + memory_cross_attention(h, mem, xa_norm_x[i], xa_norm_mem[i], xa_wq[i], xa_wkv[i],
                                       xa_q_hnorm[i], xa_k_hnorm[i], xa_wo[i])
        h = h + swiglu_ffn(h, ffn_norm[i], ffn_w13[i], ffn_w2[i])
    return h
```

```cpp
#ifndef EMU
#include <hip/hip_runtime.h>
#include <hip/hip_cooperative_groups.h>
#include <cstdio>
namespace cg = cooperative_groups;
typedef short bf16x8 __attribute__((ext_vector_type(8)));
typedef float f32x4 __attribute__((ext_vector_type(4)));
#define CG_SYNC() cg::this_grid().sync()
#define GRID_SYNC() xcd_barrier(xb)
#define MFMA16(a, b, c) __builtin_amdgcn_mfma_f32_16x16x32_bf16((a), (b), (c), 0, 0, 0)
#else
#define CG_SYNC() emu_grid_sync()
#define GRID_SYNC() emu_grid_sync()
#define MFMA16(a, b, c) emu_mfma_bf16((a), (b), (c))
#endif
#include <stdint.h>
#include <stddef.h>
#define DEV __device__ __forceinline__
#ifndef EMU
#define SETPRIO(n) __builtin_amdgcn_s_setprio(n)
#else
#define SETPRIO(n)
#endif
#ifndef EMU
#define GAS __attribute__((address_space(1)))
#else
#define GAS
#endif
#ifndef EMU
#define MEMBAR() asm volatile("" ::: "memory")
#else
#define MEMBAR()
#endif

#ifndef CFG_SEQ
#define CFG_SEQ 16384
#endif
#ifndef CFG_BATCH
#define CFG_BATCH 2
#endif
constexpr int S_ = CFG_SEQ;
constexpr int NB = CFG_BATCH;
constexpr int T_ = S_ * NB;
constexpr int NTHR = 256;
constexpr float EPS = 1e-6f;
#ifndef PM
#define PM 0xffff
#endif
#ifndef REP
#define REP 0
#endif
#ifndef GEMM_SETS
#define GEMM_SETS 1
#endif
#define NREP(bit) (((REP) & (bit)) ? 2 : 1)
constexpr int EVIN = 2464, EVIN_P = 2560, ODIN = 5152, ODIN_P = 5248, FH = 2816;

typedef unsigned short bf16_t;
typedef float f32x2 __attribute__((ext_vector_type(2)));
typedef unsigned U4 __attribute__((ext_vector_type(4)));
typedef unsigned U2 __attribute__((ext_vector_type(2)));

#ifndef EMU
DEV int launder(int v) { asm volatile("" : "+v"(v)); return v; }
#else
DEV int launder(int v) { return v; }
#endif
template <class T> DEV T* as_global(GAS T* q) { return (T*)q; }
#ifndef EMU
template <class T> DEV GAS T* launder_g(GAS T* q) { asm volatile("" : "+s"(q)); return q; }
#else
template <class T> DEV T* launder_g(T* q) { return q; }
#endif
DEV size_t launder_u64(size_t v) {
#ifndef EMU
  asm volatile("" : "+s"(v));
#endif
  return v; }
template <class T> DEV T* launder_sp(T* q) {
#ifndef EMU
  asm volatile("" : "+s"(q));
#endif
  return q; }
DEV bf16_t f2bf(float f) { unsigned u = __float_as_uint(f); u += 0x7fffu + ((u >> 16) & 1u); return (bf16_t)(u >> 16); }
DEV float bf2f(bf16_t h) { return __uint_as_float(((unsigned)h) << 16); }
#ifndef EMU
DEV unsigned pack2(float a, float b) { unsigned r; asm("v_cvt_pk_bf16_f32 %0, %1, %2" : "=v"(r) : "v"(a), "v"(b)); return r; }
DEV float exp2_(float x) { return __builtin_amdgcn_exp2f(x); }
#else
DEV unsigned pack2(float a, float b) { return (unsigned)f2bf(a) | ((unsigned)f2bf(b) << 16); }
DEV float exp2_(float x) { return exp2f(x); }
#endif
#ifndef EMU
DEV float rcp_(float x) { return __builtin_amdgcn_rcpf(x); }
#else
DEV float rcp_(float x) { return 1.0f / x; }
#endif
DEV float sigmoidf_(float x) { return rcp_(1.0f + __expf(-x)); }
DEV float siluf_(float x) { return x * rcp_(1.0f + __expf(-x)); }
#ifdef EMU
#define __logf logf
#endif
DEV float softplusf_(float x) { return fmaxf(x, 0.0f) + __logf(1.0f + __expf(-fabsf(x))); }
DEV float wave_sum(float v) { v += __shfl_xor(v, 32); v += __shfl_xor(v, 16); v += __shfl_xor(v, 8); v += __shfl_xor(v, 4); v += __shfl_xor(v, 2); v += __shfl_xor(v, 1); return v; }
DEV float reduce16(float v);
DEV float sum16(float v) { return reduce16(v); }

struct Params { const GAS float* in[42]; GAS float* out; GAS char* ws; };

constexpr size_t al256(size_t x) { return (x + 255) & ~(size_t)255; }
constexpr size_t W_EVIN = 0;
constexpr size_t W_UQ = W_EVIN + (size_t)EVIN_P * 1024 * 2;
constexpr size_t W_UKV = W_UQ + 768 * 384 * 2;
constexpr size_t W_RW2 = W_UKV + 1024 * 256 * 2;
constexpr size_t W_RA2 = W_RW2 + 512 * 64 * 2;
constexpr size_t W_RG2 = W_RA2 + 512 * 64 * 2;
constexpr size_t W_EVOUT = W_RG2 + 512 * 128 * 2;
constexpr size_t W_XQ0 = W_EVOUT + 1024 * 1024 * 2;
constexpr size_t W_XKV0 = W_XQ0 + 512 * 1024 * 2;
constexpr size_t W_XKV1 = W_XKV0 + 1024 * 1024 * 2;
constexpr size_t W_XO0 = W_XKV1 + 1024 * 1024 * 2;
constexpr size_t W_F13_0 = W_XO0 + 1024 * 512 * 2;
constexpr size_t W_F2_0 = W_F13_0 + (size_t)5632 * 1024 * 2;
constexpr size_t W0_END = W_F2_0 + (size_t)1024 * FH * 2;
constexpr size_t M_MEMN = al256(W0_END);
constexpr size_t M_MEMKV = M_MEMN + (size_t)2 * NB * 256 * 1024 * 2;
constexpr size_t M_KX = M_MEMKV + (size_t)2 * NB * 256 * 1024 * 4;
constexpr size_t M_VXT = M_KX + (size_t)2 * NB * 4 * 256 * 128 * 2;
constexpr size_t M_CNT = M_VXT + (size_t)2 * NB * 4 * 256 * 128 * 2;
constexpr size_t M_BAR = al256(M_CNT + 256);
constexpr size_t DYN0 = al256(M_BAR + 16384);
constexpr size_t W_ODIN = DYN0;
constexpr size_t W_ODOUT = W_ODIN + (size_t)ODIN_P * 1024 * 2;
constexpr size_t W_XQ1 = W_ODOUT + (size_t)1024 * 2048 * 2;
constexpr size_t W_XO1 = W_XQ1 + 512 * 1024 * 2;
constexpr size_t W_F13_1 = W_XO1 + 1024 * 512 * 2;
constexpr size_t W_F2_1 = W_F13_1 + (size_t)5632 * 1024 * 2;
constexpr size_t DYN1 = al256(W_F2_1 + (size_t)1024 * FH * 2);
constexpr size_t TT = (size_t)T_;
constexpr size_t L0_AN = DYN0;
constexpr size_t L0_P0 = L0_AN + TT * 2048;
constexpr size_t L0_QM = L0_P0;
constexpr size_t L0_KM = L0_QM + TT * 768 * 2;
constexpr size_t L0_VMT = L0_KM + TT * 768 * 2;
constexpr size_t L0_ACQ = L0_P0 + TT * EVIN * 2;
constexpr size_t L0_ACKV = L0_ACQ + TT * 384 * 2;
constexpr size_t L0_LW = L0_ACKV + TT * 256 * 2;
constexpr size_t L0_LA = L0_LW + TT * 64 * 2;
constexpr size_t L0_LG = L0_LA + TT * 64 * 2;
constexpr size_t L0_YSC = L0_ACQ;
constexpr size_t L0_KR = L0_LG + TT * 128 * 2;
constexpr size_t L0_SSR = L0_KR + TT * 32 * 4;
constexpr size_t L0_CS = L0_SSR + TT * 4;
constexpr size_t L0_SN = L0_CS + TT * 64;
constexpr size_t L0_KP = L0_SN + TT * 64;
constexpr size_t L0_KK = L0_KP + TT * 1024;
constexpr size_t L0_BV = L0_KK + TT * 1024;
constexpr size_t L0_AMIX = L0_BV + TT * 1024;
constexpr size_t L0_END = L0_AMIX + TT * 2048;
constexpr size_t X_AN = DYN1;
constexpr size_t X_QX = X_AN + TT * 2048;
constexpr size_t X_AXO = X_QX + TT * 1024;
constexpr size_t X_HID = X_AXO + TT * 1024;
constexpr size_t X_END = X_HID + TT * FH * 2;
constexpr size_t SS = (size_t)S_;
constexpr size_t O_Z = X_AN + TT * 2048;
constexpr size_t O_XR = O_Z + SS * 4096;
constexpr size_t O_XS = O_XR + SS * 6144;
constexpr size_t O_BM = O_XS + SS * 4096;
constexpr size_t O_CM = O_BM + SS * 1024;
constexpr size_t O_DT = O_CM + SS * 1024;
constexpr size_t O_DTH = O_DT + SS * 128;
constexpr size_t O_CUMH = O_DTH + SS * 128;
constexpr size_t O_CB = O_CUMH + SS * 128;
constexpr size_t O_ST = O_CB + SS * 2048;
constexpr size_t O_END = O_ST + SS * 2048;
constexpr size_t WS_NEED = (L0_END > X_END ? (L0_END > O_END ? L0_END : O_END) : (X_END > O_END ? X_END : O_END));
static_assert(WS_NEED <= ((size_t)512 << 20), "workspace plan exceeds 512 MiB");
static_assert(L0_LG + TT * 256 - L0_ACQ >= TT * 1024, "YSC fits");

constexpr int LDS_STRIDE = 144;
constexpr int SMEM_BYTES = 2 * (128 + 128) * LDS_STRIDE + 64;

DEV void convert_weight(const float* src, bf16_t* dst, int K, int N, int Npad, bool swiglu, char* smem, int bid, int nblk) {
  float* t = (float*)smem;
  int ntn = Npad / 64, ntk = K / 64, tid = threadIdx.x;
  for (int tile = bid; tile < ntn * ntk; tile += nblk) {
    int n0 = (tile % ntn) * 64, k0 = (tile / ntn) * 64;
    __syncthreads();
    for (int i = 0; i < 16; i++) { int kk = i * 4 + (tid >> 6), nn = tid & 63; int n = n0 + nn; t[kk * 65 + nn] = (n < N) ? src[(size_t)(k0 + kk) * N + n] : 0.0f; }
    __syncthreads();
    for (int i = 0; i < 16; i++) { int nn = i * 4 + (tid >> 6), kk = tid & 63; int n = n0 + nn; int row = n;
      if (swiglu) { int j = (n < FH) ? n : n - FH; row = (j >> 5) * 64 + (j & 31) + ((n < FH) ? 0 : 32); }
      dst[(size_t)row * K + k0 + kk] = f2bf(t[kk * 65 + nn]); }
  }
  __syncthreads();
}

DEV void rmsnorm_rows(const float* src, const float* g, bf16_t* dst, int rows, int gw, int nw) {
  int lane = threadIdx.x & 63;
  for (int r = gw; r < rows; r += nw) {
    const float* p = src + (size_t)r * 1024; float v[16]; float ss = 0;
#pragma unroll
    for (int i = 0; i < 4; i++) { const float4 q = *(const float4*)(p + i * 256 + lane * 4); v[i*4] = q.x; v[i*4+1] = q.y; v[i*4+2] = q.z; v[i*4+3] = q.w; ss += q.x*q.x + q.y*q.y + q.z*q.z + q.w*q.w; }
    ss = wave_sum(ss); float rs = rsqrtf(ss * (1.0f / 1024.0f) + EPS);
#pragma unroll
    for (int i = 0; i < 4; i++) { int c = i * 256 + lane * 4; U2 o; o.x = pack2(v[i*4] * rs * g[c], v[i*4+1] * rs * g[c+1]); o.y = pack2(v[i*4+2] * rs * g[c+2], v[i*4+3] * rs * g[c+3]); *(U2*)(dst + (size_t)r * 1024 + c) = o; }
  }
}

struct NoAX { static constexpr bool ON = false; DEV void chunk0(U4&, int, int) const {} DEV float scale1(int) const { return 1.0f; } };

template <int R, int MODE> DEV void g2r(U4 (&reg)[R / 32], const bf16_t* base, size_t ld, int k0, int tid) {
  const char* bp = (const char*)base; const unsigned ld2 = (unsigned)ld * 2u;
  if (MODE == 0) { const unsigned off0 = (unsigned)(tid >> 3) * ld2 + (unsigned)(tid & 7) * 16u;
#pragma unroll
    for (int i = 0; i < R / 32; i++) { const char* bi = bp + launder_u64((size_t)k0 * 2 + (size_t)i * 32 * ld2); reg[i] = *(const U4*)(bi + off0); } }
  else { constexpr int CPR = R / 8; const unsigned off0 = (unsigned)(tid / CPR) * ld2 + (unsigned)(tid % CPR) * 16u;
#pragma unroll
    for (int i = 0; i < R / 32; i++) { const char* bi = bp + launder_u64((size_t)k0 * ld2 + (size_t)i * (NTHR / CPR) * ld2); reg[i] = *(const U4*)(bi + off0); } }
}
template <int R, int MODE, class AX> DEV void r2s(char* s, U4 (&reg)[R / 32], int k0, int tid, const AX& ax) {
#pragma unroll
  for (int i = 0; i < R / 32; i++) { int c = tid + NTHR * i; U4 v = reg[i];
    if (MODE == 0) { int row = c >> 3, kc = c & 7;
      if (AX::ON) ax.chunk0(v, row, k0 + kc * 8);
      *(U4*)(s + row * LDS_STRIDE + kc * 16) = v; }
    else { int k = c / (R / 8), rc = c % (R / 8);
      float sc1 = AX::ON ? ax.scale1(k0 + k) : 1.0f;
#pragma unroll
      for (int j = 0; j < 8; j++) { bf16_t h = (bf16_t)((v[j >> 1] >> ((j & 1) * 16)) & 0xffff);
        if (AX::ON) h = f2bf(bf2f(h) * sc1);
        *(bf16_t*)(s + (rc * 8 + j) * LDS_STRIDE + k * 2) = h; } } }
}

template <int WGM, int WGN, int WMT, int WNT, int AMODE, int BMODE, class AX>
DEV void gemm_acc(f32x4 (&acc)[WMT][WNT], const bf16_t* A, size_t lda, const bf16_t* B, size_t ldb, int K, char* smem, const AX& ax) {
  constexpr int BM = WGM * WMT * 16, BN = WGN * WNT * 16;
  constexpr int SA = BM * LDS_STRIDE, SB = BN * LDS_STRIDE;
  static_assert(2 * (SA + SB) <= SMEM_BYTES, "LDS");
  char* sA0 = smem; char* sB0 = smem + SA; char* sA1 = smem + SA + SB; char* sB1 = smem + 2 * SA + SB;
  const int tid = launder((int)threadIdx.x), lane = tid & 63, wave = tid >> 6, wm = wave / WGN, wn = wave % WGN;
#if GEMM_SETS == 1
  U4 ra0[BM / 32], rb0[BN / 32];
#else
  U4 ra0[BM / 32], rb0[BN / 32], ra1[BM / 32], rb1[BN / 32];
#endif
  const int nk = K / 64;
  auto compute = [&](const char* cA, const char* cB) {
#pragma unroll
    for (int ks = 0; ks < 2; ks++) {
      bf16x8 bfr[WNT];
      const char* pa = cA + (wm * WMT * 16 + (lane & 15)) * LDS_STRIDE + ks * 64 + (lane >> 4) * 16;
      const char* pb = cB + (wn * WNT * 16 + (lane & 15)) * LDS_STRIDE + ks * 64 + (lane >> 4) * 16;
#pragma unroll
      for (int nt = 0; nt < WNT; nt++) bfr[nt] = *(const bf16x8*)(pb + nt * 16 * LDS_STRIDE);
      SETPRIO(1);
#pragma unroll
      for (int mt = 0; mt < WMT; mt++) { bf16x8 af = *(const bf16x8*)(pa + mt * 16 * LDS_STRIDE);
#pragma unroll
        for (int nt = 0; nt < WNT; nt++) acc[mt][nt] = MFMA16(af, bfr[nt], acc[mt][nt]); }
      SETPRIO(0);
    }
  };
#if GEMM_SETS == 1
  g2r<BM, AMODE>(ra0, A, lda, 0, tid); g2r<BN, BMODE>(rb0, B, ldb, 0, tid);
  __syncthreads();
  r2s<BM, AMODE>(sA0, ra0, 0, tid, ax); r2s<BN, BMODE>(sB0, rb0, 0, tid, NoAX());
  __syncthreads();
#pragma unroll 1
  for (int kt = 0; kt < nk; kt++) {
    char* cA = (kt & 1) ? sA1 : sA0; char* cB = (kt & 1) ? sB1 : sB0;
    char* nA = (kt & 1) ? sA0 : sA1; char* nB = (kt & 1) ? sB0 : sB1;
    if (kt + 1 < nk) { g2r<BM, AMODE>(ra0, A, lda, (kt + 1) * 64, tid); g2r<BN, BMODE>(rb0, B, ldb, (kt + 1) * 64, tid); }
    compute(cA, cB);
    if (kt + 1 < nk) { r2s<BM, AMODE>(nA, ra0, (kt + 1) * 64, tid, ax); r2s<BN, BMODE>(nB, rb0, (kt + 1) * 64, tid, NoAX()); }
    __syncthreads();
  }
}
#else
  g2r<BM, AMODE>(ra0, A, lda, 0, tid); g2r<BN, BMODE>(rb0, B, ldb, 0, tid);
  if (nk > 1) { g2r<BM, AMODE>(ra1, A, lda, 64, tid); g2r<BN, BMODE>(rb1, B, ldb, 64, tid); }
  __syncthreads();
  r2s<BM, AMODE>(sA0, ra0, 0, tid, ax); r2s<BN, BMODE>(sB0, rb0, 0, tid, NoAX());
  if (nk > 2) { g2r<BM, AMODE>(ra0, A, lda, 128, tid); g2r<BN, BMODE>(rb0, B, ldb, 128, tid); }
  __syncthreads();
#pragma unroll 1
  for (int t = 0; t < nk; t += 2) {
    if (t + 1 < nk) { r2s<BM, AMODE>(sA1, ra1, (t + 1) * 64, tid, ax); r2s<BN, BMODE>(sB1, rb1, (t + 1) * 64, tid, NoAX());
      if (t + 3 < nk) { g2r<BM, AMODE>(ra1, A, lda, (t + 3) * 64, tid); g2r<BN, BMODE>(rb1, B, ldb, (t + 3) * 64, tid); } }
    compute(sA0, sB0);
    __syncthreads();
    if (t + 1 >= nk) break;
    if (t + 2 < nk) { r2s<BM, AMODE>(sA0, ra0, (t + 2) * 64, tid, ax); r2s<BN, BMODE>(sB0, rb0, (t + 2) * 64, tid, NoAX());
      if (t + 4 < nk) { g2r<BM, AMODE>(ra0, A, lda, (t + 4) * 64, tid); g2r<BN, BMODE>(rb0, B, ldb, (t + 4) * 64, tid); } }
    compute(sA1, sB1);
    __syncthreads();
  }
}
#endif
template <int BM, int BN, int AMODE, int BMODE> DEV void gemm_preload(U4 (&ra)[BM / 32], U4 (&rb)[BN / 32], const bf16_t* A, size_t lda, const bf16_t* B, size_t ldb) {
  const int tid = launder((int)threadIdx.x); g2r<BM, AMODE>(ra, A, lda, 0, tid); g2r<BN, BMODE>(rb, B, ldb, 0, tid);
}
template <int WGM, int WGN, int WMT, int WNT, int AMODE, int BMODE, class AX>
DEV void gemm_acc_pre(f32x4 (&acc)[WMT][WNT], U4 (&ra0)[WGM * WMT / 2], U4 (&rb0)[WGN * WNT / 2], const bf16_t* A, size_t lda, const bf16_t* B, size_t ldb, int K, char* smem, const AX& ax) {
  constexpr int BM = WGM * WMT * 16, BN = WGN * WNT * 16;
  constexpr int SA = BM * LDS_STRIDE, SB = BN * LDS_STRIDE;
  char* sA0 = smem; char* sB0 = smem + SA; char* sA1 = smem + SA + SB; char* sB1 = smem + 2 * SA + SB;
  const int tid = launder((int)threadIdx.x), lane = tid & 63, wave = tid >> 6, wm = wave / WGN, wn = wave % WGN;
  const int nk = K / 64;
  __syncthreads();
  r2s<BM, AMODE>(sA0, ra0, 0, tid, ax); r2s<BN, BMODE>(sB0, rb0, 0, tid, NoAX());
  __syncthreads();
#pragma unroll 1
  for (int kt = 0; kt < nk; kt++) {
    const char* cA = (kt & 1) ? sA1 : sA0; const char* cB = (kt & 1) ? sB1 : sB0;
    char* nA = (kt & 1) ? sA0 : sA1; char* nB = (kt & 1) ? sB0 : sB1;
    if (kt + 1 < nk) { g2r<BM, AMODE>(ra0, A, lda, (kt + 1) * 64, tid); g2r<BN, BMODE>(rb0, B, ldb, (kt + 1) * 64, tid); }
#pragma unroll
    for (int ks = 0; ks < 2; ks++) {
      bf16x8 bfr[WNT];
      const char* pa = cA + (wm * WMT * 16 + (lane & 15)) * LDS_STRIDE + ks * 64 + (lane >> 4) * 16;
      const char* pb = cB + (wn * WNT * 16 + (lane & 15)) * LDS_STRIDE + ks * 64 + (lane >> 4) * 16;
#pragma unroll
      for (int nt = 0; nt < WNT; nt++) bfr[nt] = *(const bf16x8*)(pb + nt * 16 * LDS_STRIDE);
      SETPRIO(1);
#pragma unroll
      for (int mt = 0; mt < WMT; mt++) { bf16x8 af = *(const bf16x8*)(pa + mt * 16 * LDS_STRIDE);
#pragma unroll
        for (int nt = 0; nt < WNT; nt++) acc[mt][nt] = MFMA16(af, bfr[nt], acc[mt][nt]); }
      SETPRIO(0);
    }
    if (kt + 1 < nk) { r2s<BM, AMODE>(nA, ra0, (kt + 1) * 64, tid, ax); r2s<BN, BMODE>(nB, rb0, (kt + 1) * 64, tid, NoAX()); }
    __syncthreads();
  }
}
template <int WMT, int WNT> DEV void zero_acc(f32x4 (&acc)[WMT][WNT]) {
#pragma unroll
  for (int i = 0; i < WMT; i++)
#pragma unroll
    for (int j = 0; j < WNT; j++) { acc[i][j][0] = 0; acc[i][j][1] = 0; acc[i][j][2] = 0; acc[i][j][3] = 0; }
}

template <class EPI> DEV void gemm_phase_128(const bf16_t* A, size_t lda, const bf16_t* Bt, int M, int Npad, int K, char* smem, int bid, int nblk, EPI epi) {
  const int ntn = Npad / 128, ntm = M / 128; const int tid = launder((int)threadIdx.x), lane = tid & 63, wave = tid >> 6, wm = wave >> 1, wn = wave & 1;
  const int ntiles = ntn * ntm; const bool grouped = ((ntm & 7) == 0) && ((nblk & 7) == 0);
  const int xcd = bid & 7, li = bid >> 3, per = nblk >> 3;
  auto get_tile = [&](int it, int& tm, int& tn) -> bool {
    if (grouped) { int sidx = (it * 8 + xcd) * per + li; if (sidx >= ntiles) return false; int band = sidx / (8 * ntn), sb = sidx % (8 * ntn); tn = sb >> 3; tm = band * 8 + (sb & 7); return true; }
    int tile = bid + it * nblk; if (tile >= ntiles) return false; tn = tile % ntn; tm = tile / ntn; return true; };
  constexpr int SA = 128 * LDS_STRIDE;
  char* sA0 = smem; char* sB0 = smem + SA; char* sA1 = smem + 2 * SA; char* sB1 = smem + 3 * SA;
  const int nk = K / 64;
  U4 ra[4], rb[4];
  int tm = 0, tn = 0; bool have = get_tile(0, tm, tn);
  if (have) { g2r<128, 0>(ra, A + (size_t)tm * 128 * lda, lda, 0, tid); g2r<128, 0>(rb, Bt + (size_t)tn * 128 * K, (size_t)K, 0, tid); }
  for (int it = 0; have; it++) {
    const bf16_t* Ab = A + (size_t)tm * 128 * lda; const bf16_t* Bb = Bt + (size_t)tn * 128 * K;
    f32x4 acc[4][4]; zero_acc<4, 4>(acc);
    __syncthreads();
    r2s<128, 0>(sA0, ra, 0, tid, NoAX()); r2s<128, 0>(sB0, rb, 0, tid, NoAX());
    __syncthreads();
#pragma unroll 1
    for (int kt = 0; kt < nk; kt++) {
      const char* cA = (kt & 1) ? sA1 : sA0; const char* cB = (kt & 1) ? sB1 : sB0;
      char* nA = (kt & 1) ? sA0 : sA1; char* nB = (kt & 1) ? sB0 : sB1;
      if (kt + 1 < nk) { g2r<128, 0>(ra, Ab, lda, (kt + 1) * 64, tid); g2r<128, 0>(rb, Bb, (size_t)K, (kt + 1) * 64, tid); }
#pragma unroll
      for (int ks = 0; ks < 2; ks++) {
        bf16x8 bfr[4];
        const char* pa = cA + (wm * 64 + (lane & 15)) * LDS_STRIDE + ks * 64 + (lane >> 4) * 16;
        const char* pb = cB + (wn * 64 + (lane & 15)) * LDS_STRIDE + ks * 64 + (lane >> 4) * 16;
#pragma unroll
        for (int nt = 0; nt < 4; nt++) bfr[nt] = *(const bf16x8*)(pb + nt * 16 * LDS_STRIDE);
        SETPRIO(1);
#pragma unroll
        for (int mt = 0; mt < 4; mt++) { bf16x8 af = *(const bf16x8*)(pa + mt * 16 * LDS_STRIDE);
#pragma unroll
          for (int nt = 0; nt < 4; nt++) acc[mt][nt] = MFMA16(af, bfr[nt], acc[mt][nt]); }
        SETPRIO(0);
      }
      if (kt + 1 < nk) { r2s<128, 0>(nA, ra, (kt + 1) * 64, tid, NoAX()); r2s<128, 0>(nB, rb, (kt + 1) * 64, tid, NoAX()); }
      __syncthreads();
    }
    const int m0 = tm * 128 + wm * 64, n0 = tn * 128 + wn * 64;
    int tm2 = 0, tn2 = 0; const bool have2 = get_tile(it + 1, tm2, tn2);
    if (have2) { g2r<128, 0>(ra, A + (size_t)tm2 * 128 * lda, lda, 0, tid); g2r<128, 0>(rb, Bt + (size_t)tn2 * 128 * K, (size_t)K, 0, tid); }
    epi(acc, m0, n0);
    tm = tm2; tn = tn2; have = have2;
  }
}

DEV void gemm_resid(const bf16_t* A, size_t lda, const bf16_t* Bt, int M, int K, const float* src, float* dst, char* smem, int bid, int nblk) {
  const int lane = launder((int)threadIdx.x) & 63, c16 = lane & 15, quad = lane >> 4;
  gemm_phase_128(A, lda, Bt, M, 1024, K, smem, bid, nblk, [&](f32x4 (&acc)[4][4], int m0, int n0) {
#pragma unroll
    for (int mt = 0; mt < 4; mt++)
#pragma unroll
      for (int nt = 0; nt < 4; nt++)
#pragma unroll
        for (int j = 0; j < 4; j++) { size_t o = (size_t)(m0 + mt * 16 + quad * 4 + j) * 1024 + n0 + nt * 16 + c16; dst[o] = src[o] + acc[mt][nt][j]; }
  });
}

template <int DK, int DV, bool CAUSAL, int NQ>
DEV void attn_item(const bf16_t* Q, size_t ldq, const bf16_t* Kp, size_t ldk, const bf16_t* VT, size_t ldv, bf16_t* O, size_t ldo, int q0blk, int nkeys, char* smem) {
  constexpr int KS = DK / 32, MV = DV / 16;
  constexpr int KSTR = DK * 2 + 16;
  constexpr int SK = 64 * KSTR, SV = DV * LDS_STRIDE;
  static_assert(2 * (SK + SV) <= SMEM_BYTES, "attn LDS");
  constexpr int KCH = 64 * DK / 8 / NTHR;
  constexpr int VCH = DV * 8 / NTHR;
  const int tid = launder((int)threadIdx.x), lane = tid & 63, wave = tid >> 6, c16 = lane & 15, quad = lane >> 4;
  const int q0 = q0blk + wave * 16 * NQ;
  bf16x8 qf[NQ][KS];
#pragma unroll
  for (int nq = 0; nq < NQ; nq++)
#pragma unroll
    for (int ks = 0; ks < KS; ks++) qf[nq][ks] = *(const bf16x8*)(Q + (size_t)(q0 + nq * 16 + c16) * ldq + ks * 32 + quad * 8);
  f32x4 o[MV][NQ];
#pragma unroll
  for (int i = 0; i < MV; i++)
#pragma unroll
    for (int nq = 0; nq < NQ; nq++) o[i][nq] = f32x4{0, 0, 0, 0};
  float mrun[NQ], lrun[NQ];
#pragma unroll
  for (int nq = 0; nq < NQ; nq++) { mrun[nq] = -INFINITY; lrun[nq] = 0.f; }
  U4 rk[KCH], rv[VCH];
  const int nkt = nkeys / 64;
  auto loadKV = [&](int kt) {
#pragma unroll
    for (int i = 0; i < KCH; i++) { int c = tid + NTHR * i; int row = c / (DK / 8), kc = c % (DK / 8); rk[i] = *(const U4*)(Kp + (size_t)(kt * 64 + row) * ldk + kc * 8); }
#pragma unroll
    for (int i = 0; i < VCH; i++) { int c = tid + NTHR * i; int row = c >> 3, kc = c & 7; rv[i] = *(const U4*)(VT + (size_t)row * ldv + kt * 64 + kc * 8); }
  };
  auto storeKV = [&](char* sk, char* sv) {
#pragma unroll
    for (int i = 0; i < KCH; i++) { int c = tid + NTHR * i; int row = c / (DK / 8), kc = c % (DK / 8); *(U4*)(sk + row * KSTR + kc * 16) = rk[i]; }
#pragma unroll
    for (int i = 0; i < VCH; i++) { int c = tid + NTHR * i; int row = c >> 3, kc = c & 7; *(U4*)(sv + row * LDS_STRIDE + kc * 16) = rv[i]; }
  };
  char* sK0 = smem; char* sV0 = smem + SK; char* sK1 = smem + SK + SV; char* sV1 = smem + 2 * SK + SV;
  loadKV(0);
  __syncthreads();
  storeKV(sK0, sV0);
  __syncthreads();
  for (int kt = 0; kt < nkt; kt++) {
    char* cK = (kt & 1) ? sK1 : sK0; char* cV = (kt & 1) ? sV1 : sV0;
    if (kt + 1 < nkt) loadKV(kt + 1);
    bool active = !CAUSAL || (kt * 64 <= q0 + 16 * NQ - 1);
    if (active) {
      f32x4 s[4][NQ];
#pragma unroll
      for (int mt = 0; mt < 4; mt++)
#pragma unroll
        for (int nq = 0; nq < NQ; nq++) s[mt][nq] = f32x4{0, 0, 0, 0};
#pragma unroll
      for (int ks = 0; ks < KS; ks++)
#pragma unroll
        for (int mt = 0; mt < 4; mt++) { bf16x8 kf = *(const bf16x8*)(cK + (mt * 16 + c16) * KSTR + ks * 64 + quad * 16);

#pragma unroll
          for (int nq = 0; nq < NQ; nq++) s[mt][nq] = MFMA16(kf, qf[nq][ks], s[mt][nq]); }
      bf16x8 pf[NQ][2];
      const bool diag = CAUSAL && (kt * 64 + 63 > q0);
#pragma unroll
      for (int nq = 0; nq < NQ; nq++) {
        int qi = q0 + nq * 16 + c16; float mx = -INFINITY;
#pragma unroll
        for (int mt = 0; mt < 4; mt++)
#pragma unroll
          for (int j = 0; j < 4; j++) { if (CAUSAL && diag) { int key = kt * 64 + mt * 16 + quad * 4 + j; if (key > qi) s[mt][nq][j] = -INFINITY; } mx = fmaxf(mx, s[mt][nq][j]); }
        mx = fmaxf(mx, __shfl_xor(mx, 16)); mx = fmaxf(mx, __shfl_xor(mx, 32));
        float mnew = fmaxf(mrun[nq], mx); float alpha = exp2_(mrun[nq] - mnew); mrun[nq] = mnew;
        float ls = 0;
#pragma unroll
        for (int mt = 0; mt < 4; mt++)
#pragma unroll
          for (int j = 0; j < 4; j++) { float p = exp2_(s[mt][nq][j] - mnew); s[mt][nq][j] = p; ls += p; }
        lrun[nq] = lrun[nq] * alpha + ls;
#pragma unroll
        for (int mv = 0; mv < MV; mv++) { o[mv][nq][0] *= alpha; o[mv][nq][1] *= alpha; o[mv][nq][2] *= alpha; o[mv][nq][3] *= alpha; }
#pragma unroll
        for (int kk = 0; kk < 2; kk++) { U4 pk; pk[0] = pack2(s[2 * kk][nq][0], s[2 * kk][nq][1]); pk[1] = pack2(s[2 * kk][nq][2], s[2 * kk][nq][3]);
          pk[2] = pack2(s[2 * kk + 1][nq][0], s[2 * kk + 1][nq][1]); pk[3] = pack2(s[2 * kk + 1][nq][2], s[2 * kk + 1][nq][3]);
          pf[nq][kk] = __builtin_bit_cast(bf16x8, pk); }
      }
#pragma unroll
      for (int mv = 0; mv < MV; mv++)
#pragma unroll
        for (int kk = 0; kk < 2; kk++) {
          const char* vp = cV + (mv * 16 + c16) * LDS_STRIDE;
          U2 lo = *(const U2*)(vp + (kk * 32 + quad * 4) * 2), hi = *(const U2*)(vp + (kk * 32 + 16 + quad * 4) * 2);
          U4 vv; vv[0] = lo[0]; vv[1] = lo[1]; vv[2] = hi[0]; vv[3] = hi[1]; bf16x8 vf = __builtin_bit_cast(bf16x8, vv);

#pragma unroll
          for (int nq = 0; nq < NQ; nq++) o[mv][nq] = MFMA16(vf, pf[nq][kk], o[mv][nq]); }
    }
    if (kt + 1 < nkt) storeKV((kt & 1) ? sK0 : sK1, (kt & 1) ? sV0 : sV1);
    __syncthreads();
  }
#pragma unroll
  for (int nq = 0; nq < NQ; nq++) {
    float l = lrun[nq]; l += __shfl_xor(l, 16); l += __shfl_xor(l, 32); float inv = 1.0f / l;
    int qi = q0 + nq * 16 + c16;
#pragma unroll
    for (int mv = 0; mv < MV; mv++) { U2 w; w.x = pack2(o[mv][nq][0] * inv, o[mv][nq][1] * inv); w.y = pack2(o[mv][nq][2] * inv, o[mv][nq][3] * inv);
      *(U2*)(O + (size_t)qi * ldo + mv * 16 + quad * 4) = w; }
  }
}

#ifndef EMU
#define DPP_ADD(v, ctrl) ((v) + __builtin_bit_cast(float, __builtin_amdgcn_mov_dpp(__builtin_bit_cast(int, (v)), (ctrl), 0xF, 0xF, true)))
DEV float reduce16(float v) { v = DPP_ADD(v, 0xB1); v = DPP_ADD(v, 0x4E); v = DPP_ADD(v, 0x141); v = DPP_ADD(v, 0x140); return v; }
#else
DEV float reduce16(float v) { v += __shfl_xor(v, 1); v += __shfl_xor(v, 2); v += __shfl_xor(v, 7); v += __shfl_xor(v, 15); return v; }
#endif
DEV void rwkv_scan_worker(const Params& p, int widx, char* smem) {
  const int tid = launder((int)threadIdx.x), lane = tid & 63, wave = tid >> 6;
  const int rg = widx & 7, h = (widx >> 3) & 7, b = widx >> 6;
  const bf16_t* RSH = (const bf16_t*)as_global(p.out); const bf16_t* VSH = RSH + 2 * TT * 512;
  const float* DEC = (const float*)(as_global(p.ws) + L0_AN);
  const bf16_t* KP = (const bf16_t*)(as_global(p.ws) + L0_KP); const bf16_t* KK = (const bf16_t*)(as_global(p.ws) + L0_KK); const bf16_t* BV = (const bf16_t*)(as_global(p.ws) + L0_BV);
  bf16_t* YSC = (bf16_t*)(as_global(p.ws) + L0_YSC);
  constexpr int CH = 16, STEPF = 5 * 64 + 8;
  constexpr int NUNIT = CH * 16 + 4 * CH * 8 + CH;
  constexpr int NSTG = 128; constexpr int NR = (NUNIT + NSTG - 1) / NSTG;
  float* buf0 = (float*)smem; float* buf1 = buf0 + CH * STEPF;
  const size_t tb = (size_t)b * S_;
  const size_t hb = (size_t)h * 64;
  U4 regs[NR];
  auto sload = [&](int ch, int s) {
#pragma unroll
    for (int i = 0; i < NR; i++) { int u = s + NSTG * i; size_t t0 = tb + (size_t)ch * CH;
      if (u < CH * 16) { int tk = u >> 4, q = u & 15; regs[i] = *(const U4*)(DEC + (t0 + tk) * 512 + hb + q * 4); }
      else if (u < CH * 16 + 4 * CH * 8) { int u2 = u - CH * 16; int arr = u2 / (CH * 8), tk = (u2 % (CH * 8)) >> 3, q = u2 & 7;
        const bf16_t* src = (arr == 0) ? KK : (arr == 1) ? BV : (arr == 2) ? KP : RSH; regs[i] = *(const U4*)(src + (t0 + tk) * 512 + hb + q * 8); }
      else if (u < NUNIT) { int tk = u - (CH * 16 + 4 * CH * 8); regs[i] = *(const U4*)(VSH + (t0 + tk) * 512 + hb + rg * 8); } }
  };
  auto sstore = [&](float* buf, int s) {
#pragma unroll
    for (int i = 0; i < NR; i++) { int u = s + NSTG * i; U4 r = regs[i];
      if (u < CH * 16) { int tk = u >> 4, q = u & 15; *(U4*)(buf + tk * STEPF + q * 4) = r; }
      else if (u < NUNIT) {
        f32x4 lo, hi; lo[0] = bf2f((bf16_t)(r[0] & 0xffff)); lo[1] = bf2f((bf16_t)(r[0] >> 16)); lo[2] = bf2f((bf16_t)(r[1] & 0xffff)); lo[3] = bf2f((bf16_t)(r[1] >> 16));
        hi[0] = bf2f((bf16_t)(r[2] & 0xffff)); hi[1] = bf2f((bf16_t)(r[2] >> 16)); hi[2] = bf2f((bf16_t)(r[3] & 0xffff)); hi[3] = bf2f((bf16_t)(r[3] >> 16));
        if (u < CH * 16 + 4 * CH * 8) { int u2 = u - CH * 16; int arr = u2 / (CH * 8), tk = (u2 % (CH * 8)) >> 3, q = u2 & 7; float* dst = buf + tk * STEPF + 64 * (1 + arr) + q * 8;
          if (arr == 0) { lo = -lo; hi = -hi; }
          *(f32x4*)dst = lo; *(f32x4*)(dst + 4) = hi; }
        else { int tk = u - (CH * 16 + 4 * CH * 8); *(f32x4*)(buf + tk * STEPF + 320) = lo; *(f32x4*)(buf + tk * STEPF + 324) = hi; } } }
  };
  __syncthreads();
  if (wave >= 2) { sload(0, tid - 128); sstore(buf0, tid - 128); if (1 < S_ / CH) sload(1, tid - 128); }
  __syncthreads();
  SETPRIO(3);
  f32x2 S01 = {0.f, 0.f}, S23 = {0.f, 0.f};
  const int row = (wave & 1) * 4 + (lane >> 4), part = lane & 15;
  const int nch = S_ / CH;
  for (int ch = 0; ch < nch; ch++) {
    float* cur = (ch & 1) ? buf1 : buf0; float* nxt = (ch & 1) ? buf0 : buf1;
    if (wave >= 2) { if (ch + 1 < nch) { sstore(nxt, tid - 128); if (ch + 2 < nch) sload(ch + 2, tid - 128); } }
    else {
      f32x4 Wq[2], Aq[2], Bq[2], Kq[2], Rq[2]; float Vq[2]; float yv[4];
      { const float* sp = cur + part * 4; Wq[0] = *(const f32x4*)(sp); Aq[0] = *(const f32x4*)(sp + 64); Bq[0] = *(const f32x4*)(sp + 128); Kq[0] = *(const f32x4*)(sp + 192); Rq[0] = *(const f32x4*)(sp + 256); Vq[0] = cur[320 + row]; }
#pragma unroll
      for (int st = 0; st < CH; st++) {
        if (st + 1 < CH) { const float* sp = cur + (st + 1) * STEPF + part * 4; const int n = (st + 1) & 1;
          Wq[n] = *(const f32x4*)(sp); Aq[n] = *(const f32x4*)(sp + 64); Bq[n] = *(const f32x4*)(sp + 128); Kq[n] = *(const f32x4*)(sp + 192); Rq[n] = *(const f32x4*)(sp + 256); Vq[n] = cur[(st + 1) * STEPF + 320 + row]; }
        const int c = st & 1;
        const f32x4 w = Wq[c], a = Aq[c], bb = Bq[c], k = Kq[c], r = Rq[c]; const float vr = Vq[c];
        f32x2 w01 = {w[0], w[1]}, w23 = {w[2], w[3]}, a01 = {a[0], a[1]}, a23 = {a[2], a[3]}, b01 = {bb[0], bb[1]}, b23 = {bb[2], bb[3]};
        f32x2 k01 = {k[0], k[1]}, k23 = {k[2], k[3]}, r01 = {r[0], r[1]}, r23 = {r[2], r[3]};
        f32x2 sp2 = S01 * a01 + S23 * a23;
        float sa = reduce16(sp2[0] + sp2[1]);
        f32x2 sa2 = {sa, sa}, vr2 = {vr, vr};
        S01 = S01 * w01 + (sa2 * b01 + vr2 * k01);
        S23 = S23 * w23 + (sa2 * b23 + vr2 * k23);
        f32x2 yp2 = S01 * r01 + S23 * r23;
        yv[st & 3] = reduce16(yp2[0] + yp2[1]);
        if ((st & 3) == 3) { if (part == 0) { bf16_t* yp = YSC + (tb + (size_t)ch * CH + (st - 3)) * 512 + hb + rg * 8 + row; yp[0] = f2bf(yv[0]); yp[512] = f2bf(yv[1]); yp[1024] = f2bf(yv[2]); yp[1536] = f2bf(yv[3]); } }
      }
    }
    __syncthreads();
  }
  SETPRIO(0);
}

#ifndef EMU
#define XB_TMO      128
#define XB_XCNT(j)  (256  + 64 * (j))
#define XB_XSUB(j)  (1280 + 64 * (j))
#define XB_XGEN(j)  (2304 + 64 * (j))
#define XB_TOP      3328
#define XB_TOPGEN   3392
#define XCD_BAR_WORDS 3456
#define XB_SPIN_CAP (1u << 18)
#define LAS __attribute__((address_space(3)))

__device__ __forceinline__ unsigned xb_ld(unsigned* p)              { return __hip_atomic_load(p, __ATOMIC_RELAXED, __HIP_MEMORY_SCOPE_AGENT); }
__device__ __forceinline__ unsigned xb_add(unsigned* p, unsigned v) { return __hip_atomic_fetch_add(p, v, __ATOMIC_RELAXED, __HIP_MEMORY_SCOPE_AGENT); }
__device__ __forceinline__ unsigned xb_xcc_id() { return (unsigned)__builtin_amdgcn_s_getreg((3 << 11) | 20) & 0xFu; }
#define XB_SPIN(cond, bar) do { unsigned _sp = 0; while (cond) { __builtin_amdgcn_s_sleep(1); \
    if ((++_sp & 255u) == 0u) { if (xb_ld(&(bar)[XB_TMO])) break; if (_sp > XB_SPIN_CAP) { atomicAdd(&(bar)[XB_TMO], 1u); break; } } } } while (0)

struct XcdBarrier {
    unsigned* bar; unsigned x;
    volatile LAS unsigned* st;
};

__device__ __forceinline__ XcdBarrier xcd_barrier_post(unsigned* bar, volatile LAS unsigned* st) {
    XcdBarrier b; b.bar = bar; b.x = xb_xcc_id(); b.st = st;
    if (threadIdx.x == 0) (void)xb_add(&bar[XB_XCNT(b.x)], 1u);
    return b;
}
__device__ __forceinline__ void xcd_barrier_complete(unsigned* bar, unsigned x, unsigned& nloc, unsigned& nx) {
    const unsigned G = gridDim.x * gridDim.y * gridDim.z;
    unsigned sum, cnt, mine, sp = 0u;
    for (;;) {
        sum = 0u; cnt = 0u; mine = 0u;
#pragma unroll
        for (unsigned j = 0; j < 16; ++j) { const unsigned c = xb_ld(&bar[XB_XCNT(j)]); sum += c; cnt += (c > 0u) ? 1u : 0u; mine = (j == x) ? c : mine; }
        if (sum == G) break;
        __builtin_amdgcn_s_sleep(1);
        if ((++sp & 255u) == 0u) { if (xb_ld(&bar[XB_TMO])) break; if (sp > XB_SPIN_CAP) { atomicAdd(&bar[XB_TMO], 1u); break; } }
    }
    nloc = mine > 0u ? mine : 1u; nx = cnt > 0u ? cnt : 1u;
}

__device__ __forceinline__ void xcd_barrier(const XcdBarrier& b) {
    asm volatile("s_waitcnt vmcnt(0)" ::: "memory");
    __syncthreads();
    if (threadIdx.x == 0) {
        unsigned* bar = b.bar;
        __builtin_amdgcn_s_waitcnt(0);
        unsigned nloc = b.st[0], nx = b.st[1];
        if (nloc == 0u) { xcd_barrier_complete(bar, b.x, nloc, nx); b.st[0] = nloc; b.st[1] = nx; }
        const unsigned old = xb_add(&bar[XB_XSUB(b.x)], 1u);
        const unsigned gen = old / nloc;
        if (old + 1u == (gen + 1u) * nloc) {
            __builtin_amdgcn_fence(__ATOMIC_RELEASE, "agent");
            asm volatile("s_waitcnt vmcnt(0)" ::: "memory");
            const unsigned og = xb_add(&bar[XB_TOP], 1u);
            const unsigned tg = og / nx;
            if (og + 1u == (tg + 1u) * nx) xb_add(&bar[XB_TOPGEN], 1u);
            else XB_SPIN(xb_ld(&bar[XB_TOPGEN]) == tg, bar);
            __builtin_amdgcn_fence(__ATOMIC_ACQUIRE, "agent");
            xb_add(&bar[XB_XGEN(b.x)], 1u);
            asm volatile("s_waitcnt vmcnt(0)" ::: "memory");
        } else {
            XB_SPIN(xb_ld(&bar[XB_XGEN(b.x)]) == gen, bar);
            __builtin_amdgcn_fence(__ATOMIC_ACQUIRE, "agent");
            asm volatile("s_waitcnt vmcnt(0)" ::: "memory");
        }
    }
    __syncthreads();
}

#endif
struct AXst { const float* dth; const float* cmh; float cend; static constexpr bool ON = true;
  DEV void chunk0(U4&, int, int) const {}
  DEV float scale1(int k) const { return dth[k] * __expf(cend - cmh[k]); } };
struct AXy { const float* dth; const float* cmh; int l0; static constexpr bool ON = true;
  DEV float scale1(int) const { return 1.0f; }
  DEV void chunk0(U4& v, int m, int k) const { const int l = l0 + m; const float cl = cmh[l];
    const f32x4 c0 = *(const f32x4*)(cmh + k), c1 = *(const f32x4*)(cmh + k + 4), d0 = *(const f32x4*)(dth + k), d1 = *(const f32x4*)(dth + k + 4);
#pragma unroll
    for (int j = 0; j < 4; j++) { const float ca = (j < 2) ? c0[2 * j] : c1[2 * j - 4], cb = (j < 2) ? c0[2 * j + 1] : c1[2 * j - 3];
      const float da = (j < 2) ? d0[2 * j] : d1[2 * j - 4], db = (j < 2) ? d0[2 * j + 1] : d1[2 * j - 3];
      float a = bf2f((bf16_t)(v[j] & 0xffff)), b = bf2f((bf16_t)(v[j] >> 16));
      a = (k + 2 * j <= l) ? a * __expf(cl - ca) * da : 0.f; b = (k + 2 * j + 1 <= l) ? b * __expf(cl - cb) * db : 0.f;
      v[j] = pack2(a, b); } } };
__global__ void __launch_bounds__(NTHR, 2) fwd_megakernel(Params p) {
#ifndef EMU
  extern __shared__ __attribute__((aligned(16))) char smem_[];
  char* smem = smem_;
#else
  char* smem = emu_cur->blk->smem;
#endif
  int tid = threadIdx.x, lane = tid & 63, wave = tid >> 6, c16 = lane & 15, quad = lane >> 4;
  const int bid = blockIdx.x, nblk = gridDim.x;
  int gw = bid * 4 + wave; const int nw = nblk * 4;
  int gt = bid * NTHR + tid; const int nt_all = nblk * NTHR;
  GAS char* wsg = p.ws; GAS float* hbg = p.out;
  char* ws = as_global(wsg);
  const float* x = as_global(p.in[0]); const float* mem = as_global(p.in[1]); const int* pos = (const int*)as_global(p.in[2]);
  float* hbuf = as_global(hbg);
  auto rederive = [&]() { tid = launder(tid); lane = tid & 63; wave = tid >> 6; c16 = lane & 15; quad = lane >> 4; gw = bid * 4 + wave; gt = bid * NTHR + tid; wsg = launder_g(wsg); hbg = launder_g(hbg); ws = as_global(wsg); hbuf = as_global(hbg); };
  auto rmap = [&](int it) { return ((nblk & 7) == 0) ? ((it * 8 + (bid & 7)) * (nblk >> 3) + (bid >> 3)) : (bid + it * nblk); };
  int* cnt = (int*)(ws + M_CNT);
  auto WB = [&](size_t off) { return (bf16_t*)(ws + off); };

#ifndef EMU
  volatile LAS unsigned* xst = (volatile LAS unsigned*)(smem + SMEM_BYTES - 48);
  unsigned* xbar = (unsigned*)(ws + M_BAR);
  if (tid == 0) { xst[0] = 0u; xst[1] = 0u; }
  if (bid == 0) for (int i = tid; i < XCD_BAR_WORDS; i += NTHR) xbar[i] = 0u;
#endif
  for (int rep0_ = 0; rep0_ < NREP(4); rep0_++) {
  convert_weight(as_global(p.in[4]), WB(W_EVIN), 1024, EVIN, EVIN_P, false, smem, bid, nblk);
  convert_weight(as_global(p.in[6]), WB(W_UQ), 384, 768, 768, false, smem, bid, nblk);
  convert_weight(as_global(p.in[8]), WB(W_UKV), 256, 1024, 1024, false, smem, bid, nblk);
  convert_weight(as_global(p.in[13]), WB(W_RW2), 64, 512, 512, false, smem, bid, nblk);
  convert_weight(as_global(p.in[15]), WB(W_RA2), 64, 512, 512, false, smem, bid, nblk);
  convert_weight(as_global(p.in[16]), WB(W_RG2), 128, 512, 512, false, smem, bid, nblk);
  convert_weight(as_global(p.in[22]), WB(W_EVOUT), 1024, 1024, 1024, false, smem, bid, nblk);
  convert_weight(as_global(p.in[34]), WB(W_XQ0), 1024, 512, 512, false, smem, bid, nblk);
  convert_weight(as_global(p.in[35]), WB(W_XKV0), 1024, 1024, 1024, false, smem, bid, nblk);
  convert_weight(as_global(p.in[35]) + (size_t)1024 * 1024, WB(W_XKV1), 1024, 1024, 1024, false, smem, bid, nblk);
  convert_weight(as_global(p.in[38]), WB(W_XO0), 512, 1024, 1024, false, smem, bid, nblk);
  convert_weight(as_global(p.in[40]), WB(W_F13_0), 1024, 2 * FH, 2 * FH, true, smem, bid, nblk);
  convert_weight(as_global(p.in[41]), WB(W_F2_0), FH, 1024, 1024, false, smem, bid, nblk);
  rmsnorm_rows(x, as_global(p.in[3]), WB(L0_AN), T_, gw, nw);
  rmsnorm_rows(mem, as_global(p.in[33]), WB(M_MEMN), NB * 256, gw, nw);
  rmsnorm_rows(mem, as_global(p.in[33]) + 1024, WB(M_MEMN) + (size_t)NB * 256 * 1024, NB * 256, gw, nw);
  }
  if (gt < 16) cnt[gt] = 0;
  CG_SYNC(); rederive();
#ifndef EMU
  XcdBarrier xb = xcd_barrier_post(xbar, xst);
#endif

  for (int rep1_ = 0; rep1_ < NREP(64); rep1_++) {
    bf16_t* P0 = WB(L0_P0);
    gemm_phase_128(WB(L0_AN), 1024, WB(W_EVIN), T_, EVIN_P, 1024, smem, bid, nblk, [&](f32x4 (&acc)[4][4], int m0, int n0) {
#pragma unroll
      for (int mt = 0; mt < 4; mt++)
#pragma unroll
        for (int nt = 0; nt < 4; nt++) { int col = n0 + nt * 16 + c16; if (col < EVIN) {
#pragma unroll
          for (int j = 0; j < 4; j++) P0[(size_t)(m0 + mt * 16 + quad * 4 + j) * EVIN + col] = f2bf(acc[mt][nt][j]); } }
    });
    for (int i = 0; i < 2; i++) {
      float* KV = (float*)(ws + M_MEMKV) + (size_t)i * NB * 256 * 1024;
      gemm_phase_128(WB(M_MEMN) + (size_t)i * NB * 256 * 1024, 1024, WB(i ? W_XKV1 : W_XKV0), NB * 256, 1024, 1024, smem, bid, nblk, [&](f32x4 (&acc)[4][4], int m0, int n0) {
#pragma unroll
        for (int mt = 0; mt < 4; mt++)
#pragma unroll
          for (int nt = 0; nt < 4; nt++)
#pragma unroll
            for (int j = 0; j < 4; j++) KV[(size_t)(m0 + mt * 16 + quad * 4 + j) * 1024 + n0 + nt * 16 + c16] = acc[mt][nt][j];
      });
    }
  }
  GRID_SYNC(); rederive();

  for (int rep2_ = 0; rep2_ < NREP(8); rep2_++) {
    const bf16_t* P0 = WB(L0_P0);
    bf16_t* ACQ = WB(L0_ACQ); bf16_t* ACKV = WB(L0_ACKV); bf16_t* LW = WB(L0_LW); bf16_t* LA = WB(L0_LA); bf16_t* LG = WB(L0_LG);
    float* KR = (float*)(ws + L0_KR); float* SSR = (float*)(ws + L0_SSR);
    bf16_t* RSH = (bf16_t*)as_global(p.out); bf16_t* KSH = RSH + TT * 512; bf16_t* VSH = RSH + 2 * TT * 512;
    const float* qn = as_global(p.in[5]); const float* kvn = as_global(p.in[7]); const float* khn = as_global(p.in[10]); const float* mu = as_global(p.in[11]);
    for (int t = gw; t < T_; t += nw) {
      const bf16_t* pr = P0 + (size_t)t * EVIN; int s = t % S_;
      float v[6]; float ss = 0;
#pragma unroll
      for (int i = 0; i < 6; i++) { v[i] = bf2f(pr[lane + 64 * i]); ss += v[i] * v[i]; }
      ss = wave_sum(ss); float rs = rsqrtf(ss * (1.0f / 384.0f) + EPS);
#pragma unroll
      for (int i = 0; i < 6; i++) ACQ[(size_t)t * 384 + lane + 64 * i] = f2bf(v[i] * rs * qn[lane + 64 * i]);
      ss = 0;
#pragma unroll
      for (int i = 0; i < 4; i++) { v[i] = bf2f(pr[384 + lane + 64 * i]); ss += v[i] * v[i]; }
      ss = wave_sum(ss); rs = rsqrtf(ss * (1.0f / 256.0f) + EPS);
#pragma unroll
      for (int i = 0; i < 4; i++) ACKV[(size_t)t * 256 + lane + 64 * i] = f2bf(v[i] * rs * kvn[lane + 64 * i]);
      float kr = (lane < 32) ? bf2f(pr[640 + lane]) : 0.f;
      float ssr = wave_sum(kr * kr);
      float xg = kr * ((lane < 32) ? khn[64 + lane] : 0.f);
      float other = __shfl_xor(xg, 16);
      int fi = lane & 15; float ang = (float)pos[t] * powf(10000.0f, -(float)fi / 16.0f);
      float cs = cosf(ang), sn = sinf(ang);
      float ro = (lane & 16) ? (xg * cs + other * sn) : (xg * cs - other * sn);
      if (lane < 32) KR[(size_t)t * 32 + lane] = ro;
      if (lane == 0) SSR[t] = ssr;
      if (lane < 16) { ((float*)(ws + L0_CS))[(size_t)t * 16 + lane] = cs; ((float*)(ws + L0_SN))[(size_t)t * 16 + lane] = sn; }
#pragma unroll 4
      for (int i = 0; i < 28; i++) { int j = lane + 64 * i; float cur = bf2f(pr[672 + j]); float prev = (s == 0) ? 0.f : bf2f(pr[672 + j - EVIN]);
        float pv = cur + (prev - cur) * mu[j];
        if (i < 8) RSH[(size_t)t * 512 + j] = f2bf(pv);
        else if (i < 16) KSH[(size_t)t * 512 + j - 512] = f2bf(pv);
        else if (i < 24) VSH[(size_t)t * 512 + j - 1024] = f2bf(pv);
        else if (i < 25) LW[(size_t)t * 64 + j - 1536] = f2bf(tanhf(pv));
        else if (i < 26) LA[(size_t)t * 64 + j - 1600] = f2bf(pv);
        else LG[(size_t)t * 128 + j - 1664] = f2bf(sigmoidf_(pv)); }
    }
    for (int it = gw; it < 2 * NB * 256 * 4; it += nw) {
      int hh = it & 3, m = (it >> 2) % (NB * 256), li = it / (NB * 256 * 4); int bb = m / 256, mm = m % 256;
      const float* kvrow = (const float*)(ws + M_MEMKV) + ((size_t)li * NB * 256 + m) * 1024;
      float k0 = kvrow[hh * 128 + lane], k1 = kvrow[hh * 128 + 64 + lane];
      float ss = wave_sum(k0 * k0 + k1 * k1); float rs = rsqrtf(ss * (1.0f / 128.0f) + EPS);
      const float* kg = as_global(p.in[37]) + li * 128;
      bf16_t* KX = WB(M_KX) + (((size_t)li * NB + bb) * 4 + hh) * 256 * 128;
      KX[mm * 128 + lane] = f2bf(k0 * rs * kg[lane]); KX[mm * 128 + 64 + lane] = f2bf(k1 * rs * kg[64 + lane]);
      bf16_t* VX = WB(M_VXT) + (((size_t)li * NB + bb) * 4 + hh) * 128 * 256;
      VX[lane * 256 + mm] = f2bf(kvrow[512 + hh * 128 + lane]); VX[(64 + lane) * 256 + mm] = f2bf(kvrow[512 + hh * 128 + 64 + lane]);
    }
  }
  GRID_SYNC(); rederive();

  for (int rep3_ = 0; rep3_ < NREP(128); rep3_++) {
    const int MT = T_ / 128;
    const int nQ = MT * 8, nKV = MT * 8, nW = MT * 4, nA = MT * 4, nG = MT * 4;
    const float* SSR = (const float*)(ws + L0_SSR); const float* KR = (const float*)(ws + L0_KR);
    for (int it_ = 0, tile; (tile = rmap(it_)) < nQ + nKV + nW + nA + nG; it_++) {
      if (!(PM & 2)) break;
      if (tile < nQ) {
        int hh = tile % 8, tm = tile / 8;
        f32x4 acc[2][6]; zero_acc<2, 6>(acc);
        gemm_acc<4, 1, 2, 6, 0, 0, NoAX>(acc, WB(L0_ACQ) + (size_t)tm * 128 * 384, 384, WB(W_UQ) + (size_t)hh * 96 * 384, 384, 384, smem, NoAX());
        const float* qh = as_global(p.in[9]); bf16_t* QM = WB(L0_QM);
        const float* CSb = (const float*)(ws + L0_CS); const float* SNb = (const float*)(ws + L0_SN);
#pragma unroll
        for (int mt = 0; mt < 2; mt++)
#pragma unroll
          for (int j = 0; j < 4; j++) { int t = tm * 128 + wave * 32 + mt * 16 + quad * 4 + j; float ss = 0;
#pragma unroll
            for (int nt = 0; nt < 6; nt++) ss += acc[mt][nt][j] * acc[mt][nt][j];
            ss = sum16(ss); float rs = rsqrtf(ss * (1.0f / 96.0f) + EPS);
            float vals[6];
#pragma unroll
            for (int nt = 0; nt < 6; nt++) vals[nt] = acc[mt][nt][j] * rs * qh[nt * 16 + c16];
            float cs = CSb[(size_t)t * 16 + c16], sn = SNb[(size_t)t * 16 + c16];
            float x1 = vals[4], x2 = vals[5]; vals[4] = x1 * cs - x2 * sn; vals[5] = x2 * cs + x1 * sn;
            int bb = t / S_, s = t % S_; bf16_t* dst = QM + ((size_t)(bb * 8 + hh) * S_ + s) * 96;
            const float scale = 0.10206207261596577f * 1.4426950408889634f;
#pragma unroll
            for (int nt = 0; nt < 6; nt++) dst[nt * 16 + c16] = f2bf(vals[nt] * scale);
            MEMBAR(); }
      } else if (tile < nQ + nKV) {
        int tl = tile - nQ; int hh = tl % 8, tm = tl / 8;
        f32x4 acc[2][8]; zero_acc<2, 8>(acc);
        gemm_acc<4, 1, 2, 8, 0, 0, NoAX>(acc, WB(L0_ACKV) + (size_t)tm * 128 * 256, 256, WB(W_UKV) + (size_t)hh * 128 * 256, 256, 256, smem, NoAX());
        const float* kh = as_global(p.in[10]); bf16_t* KM = WB(L0_KM); bf16_t* VMT = WB(L0_VMT);
#pragma unroll
        for (int mt = 0; mt < 2; mt++) {
          int tbase = tm * 128 + wave * 32 + mt * 16 + quad * 4; int bb = tbase / S_, s0 = tbase % S_;
#pragma unroll
          for (int j = 0; j < 4; j++) { int t = tbase + j; float ss = 0;
#pragma unroll
            for (int nt = 0; nt < 4; nt++) ss += acc[mt][nt][j] * acc[mt][nt][j];
            ss = sum16(ss) + SSR[t]; float rs = rsqrtf(ss * (1.0f / 96.0f) + EPS);
            bf16_t* dst = KM + ((size_t)(bb * 8 + hh) * S_ + s0 + j) * 96;
#pragma unroll
            for (int nt = 0; nt < 4; nt++) dst[nt * 16 + c16] = f2bf(acc[mt][nt][j] * rs * kh[nt * 16 + c16]);
            dst[64 + c16] = f2bf(rs * KR[(size_t)t * 32 + c16]); dst[80 + c16] = f2bf(rs * KR[(size_t)t * 32 + 16 + c16]); MEMBAR(); }
#pragma unroll
          for (int nt = 4; nt < 8; nt++) { U2 w; w.x = pack2(acc[mt][nt][0], acc[mt][nt][1]); w.y = pack2(acc[mt][nt][2], acc[mt][nt][3]);
            *(U2*)(VMT + ((size_t)(bb * 8 + hh) * 64 + (nt - 4) * 16 + c16) * S_ + s0) = w; }
        }
      } else {
        int tl = tile - nQ - nKV; int which = tl / nW; tl %= nW; int tn = tl % 4, tm = tl / 4;
        f32x4 acc[4][4]; zero_acc<4, 4>(acc);
        int m0 = tm * 128 + (wave >> 1) * 64, n0 = tn * 128 + (wave & 1) * 64;
        if (which == 0) {
          gemm_acc<2, 2, 4, 4, 0, 0, NoAX>(acc, WB(L0_LW) + (size_t)tm * 128 * 64, 64, WB(W_RW2) + (size_t)tn * 128 * 64, 64, 64, smem, NoAX());
          float* DEC = (float*)(ws + L0_AN); const float* w0 = as_global(p.in[12]);
#pragma unroll
          for (int mt = 0; mt < 4; mt++)
#pragma unroll
            for (int nt = 0; nt < 4; nt++) { int col = n0 + nt * 16 + c16;
#pragma unroll
              for (int j = 0; j < 4; j++) { float z = w0[col] + acc[mt][nt][j]; float wl = -softplusf_(-z) - 0.5f; DEC[(size_t)(m0 + mt * 16 + quad * 4 + j) * 512 + col] = __expf(-__expf(wl)); } }
        } else if (which == 1) {
          gemm_acc<2, 2, 4, 4, 0, 0, NoAX>(acc, WB(L0_LA) + (size_t)tm * 128 * 64, 64, WB(W_RA2) + (size_t)tn * 128 * 64, 64, 64, smem, NoAX());
          const bf16_t* KSH = (const bf16_t*)as_global(p.out) + TT * 512; const float* a0 = as_global(p.in[14]); const float* k_k = as_global(p.in[17]); const float* k_a = as_global(p.in[18]);
          bf16_t* KP = WB(L0_KP); bf16_t* KK = WB(L0_KK); bf16_t* BV = WB(L0_BV);
#pragma unroll
          for (int mt = 0; mt < 4; mt++)
#pragma unroll
            for (int j = 0; j < 4; j++) { size_t t = (size_t)(m0 + mt * 16 + quad * 4 + j); float kv[4], kkv[4]; float ss = 0;
#pragma unroll
              for (int nt = 0; nt < 4; nt++) { int col = n0 + nt * 16 + c16; kv[nt] = bf2f(KSH[t * 512 + col]); kkv[nt] = kv[nt] * k_k[col]; ss += kkv[nt] * kkv[nt]; }
              ss = sum16(ss); float inv = 1.0f / fmaxf(sqrtf(ss), 1e-12f);
#pragma unroll
              for (int nt = 0; nt < 4; nt++) { int col = n0 + nt * 16 + c16; float a = sigmoidf_(a0[col] + acc[mt][nt][j]); float kk = kkv[nt] * inv;
                KP[t * 512 + col] = f2bf(kv[nt] * (1.0f + (a - 1.0f) * k_a[col])); KK[t * 512 + col] = f2bf(kk); BV[t * 512 + col] = f2bf(kk * a); }
              MEMBAR(); }
        } else {
          gemm_acc<2, 2, 4, 4, 0, 0, NoAX>(acc, WB(L0_LG) + (size_t)tm * 128 * 128, 128, WB(W_RG2) + (size_t)tn * 128 * 128, 128, 128, smem, NoAX());
          bf16_t* G = (bf16_t*)as_global(p.out) + 3 * TT * 512;
#pragma unroll
          for (int mt = 0; mt < 4; mt++)
#pragma unroll
            for (int nt = 0; nt < 4; nt++)
#pragma unroll
              for (int j = 0; j < 4; j++) G[(size_t)(m0 + mt * 16 + quad * 4 + j) * 512 + n0 + nt * 16 + c16] = f2bf(acc[mt][nt][j]);
        }
      }
    }
  }
  GRID_SYNC(); rederive();

  for (int rep_ = 0; rep_ < NREP(2); rep_++) {
    const int nscan = NB * 64, nqb = S_ / 128, nattn = NB * 8 * nqb;
    int* sitem = (int*)(smem + SMEM_BYTES - 16);
    for (;;) {
      __syncthreads();
      if (tid == 0) *sitem = atomicAdd(&cnt[rep_], 1);
      __syncthreads();
      int item = *sitem;
      if (item >= nscan + nattn) break;
      if (item < nscan) { if (PM & 4) rwkv_scan_worker(p, item, smem); }
      else if (PM & 8) { int a = item - nscan; int qb = nqb - 1 - a / (NB * 8); int bh = a % (NB * 8); int bb = bh / 8, hh = bh % 8;
        attn_item<96, 64, true, 2>(WB(L0_QM) + (size_t)bh * S_ * 96, 96, WB(L0_KM) + (size_t)bh * S_ * 96, 96, WB(L0_VMT) + (size_t)bh * 64 * S_, (size_t)S_,
                                WB(L0_AMIX) + (size_t)bb * S_ * 1024 + hh * 64, 1024, qb * 128, (qb + 1) * 128, smem); }
    }
  }
  GRID_SYNC(); rederive();

  for (int rep6_ = 0; rep6_ < NREP(16); rep6_++) {
    const bf16_t* YSC = WB(L0_YSC); const bf16_t* RSH = (const bf16_t*)as_global(p.out); const bf16_t* VSH = RSH + 2 * TT * 512; const bf16_t* G = RSH + 3 * TT * 512;
    const bf16_t* KP = WB(L0_KP); bf16_t* AMIX = WB(L0_AMIX);
    const float* r_k = as_global(p.in[19]); const float* ln_g = as_global(p.in[20]); const float* ln_b = as_global(p.in[21]);
    for (int it = gw; it < T_ * 8; it += nw) { size_t t = it >> 3; int hh = it & 7; size_t idx = t * 512 + hh * 64 + lane; int ch = hh * 64 + lane;
      float y = bf2f(YSC[idx]); float mean = wave_sum(y) * (1.0f / 64.0f); float d = y - mean; float var = wave_sum(d * d) * (1.0f / 64.0f);
      float yn = d * rsqrtf(var + 64e-5f) * ln_g[ch] + ln_b[ch];
      float r = bf2f(RSH[idx]), k = bf2f(KP[idx]), v = bf2f(VSH[idx]);
      float bon = wave_sum(r * k * r_k[ch]) * v;
      AMIX[t * 1024 + 512 + ch] = f2bf((yn + bon) * bf2f(G[idx])); }
  }
  GRID_SYNC(); rederive();

  for (int r_ = 0; r_ < NREP(2048); r_++) gemm_resid(WB(L0_AMIX), 1024, WB(W_EVOUT), T_, 1024, x, hbuf, smem, bid, nblk);
  GRID_SYNC(); rederive();

#pragma unroll
  for (int layer = 0; layer < 2; layer++) {
    if (layer == 1 && (PM & 32)) {
      for (int r_ = 0; r_ < NREP(32); r_++) rmsnorm_rows(hbuf, as_global(p.in[23]), WB(X_AN), T_, gw, nw);
      GRID_SYNC(); rederive();
      for (int bb = 0; bb < NB; bb++) {
        bf16_t* Z = WB(O_Z); bf16_t* XR = WB(O_XR); bf16_t* XS = WB(O_XS); bf16_t* BM = WB(O_BM); bf16_t* CM = WB(O_CM);
        float* DT = (float*)(ws + O_DT); float* DTH = (float*)(ws + O_DTH); float* CUMH = (float*)(ws + O_CUMH);
        bf16_t* CB = WB(O_CB); bf16_t* ST = WB(O_ST);
        for (int ri_ = 0; ri_ < NREP(256); ri_++) { const float* dtb = as_global(p.in[27]);
          gemm_phase_128(WB(X_AN) + (size_t)bb * S_ * 1024, 1024, WB(W_ODIN), S_, ODIN_P, 1024, smem, bid, nblk, [&](f32x4 (&acc)[4][4], int m0, int n0) {
#pragma unroll
            for (int mt = 0; mt < 4; mt++)
#pragma unroll
              for (int nt = 0; nt < 4; nt++) { int col = n0 + nt * 16 + c16;
#pragma unroll
                for (int j = 0; j < 4; j++) { size_t r = (size_t)(m0 + mt * 16 + quad * 4 + j); float v = acc[mt][nt][j];
                  if (col < 2048) Z[r * 2048 + col] = f2bf(v);
                  else if (col < 5120) XR[r * 3072 + col - 2048] = f2bf(v);
                  else if (col < ODIN) DT[r * 32 + col - 5120] = softplusf_(v + dtb[col - 5120]); } }
          }); }
        GRID_SYNC(); rederive();
        for (int rc_ = 0; rc_ < NREP(256); rc_++) { const float* cw = as_global(p.in[25]); const float* cb = as_global(p.in[26]); const float* alog = as_global(p.in[28]);
          const int nrun = S_ / 8;
          for (int it = gt; it < nrun * 384; it += nt_all) { int cc = it % 384, run = it / 384; int ch0 = cc * 8; int t0 = run * 8;
            float hist[3][8];
#pragma unroll
            for (int d = 0; d < 3; d++) { int tt = t0 - 3 + d;
              if (tt >= 0) { U4 q = *(const U4*)(XR + (size_t)tt * 3072 + ch0);
#pragma unroll
                for (int e = 0; e < 4; e++) { hist[d][2 * e] = bf2f((bf16_t)(q[e] & 0xffff)); hist[d][2 * e + 1] = bf2f((bf16_t)(q[e] >> 16)); } }
              else {
#pragma unroll
                for (int e = 0; e < 8; e++) hist[d][e] = 0.f; } }
            float w0[8], w1[8], w2[8], w3[8], bs[8];
#pragma unroll
            for (int e = 0; e < 8; e++) { w0[e] = cw[ch0 + e]; w1[e] = cw[3072 + ch0 + e]; w2[e] = cw[2 * 3072 + ch0 + e]; w3[e] = cw[3 * 3072 + ch0 + e]; bs[e] = cb[ch0 + e]; }
            for (int i = 0; i < 8; i++) { int tt = t0 + i; U4 q = *(const U4*)(XR + (size_t)tt * 3072 + ch0); float cur[8]; unsigned ov[4];
#pragma unroll
              for (int e = 0; e < 4; e++) { cur[2 * e] = bf2f((bf16_t)(q[e] & 0xffff)); cur[2 * e + 1] = bf2f((bf16_t)(q[e] >> 16)); }
              float res[8];
#pragma unroll
              for (int e = 0; e < 8; e++) { float a = bs[e] + w0[e] * hist[0][e] + w1[e] * hist[1][e] + w2[e] * hist[2][e] + w3[e] * cur[e]; res[e] = siluf_(a); hist[0][e] = hist[1][e]; hist[1][e] = hist[2][e]; hist[2][e] = cur[e]; }
#pragma unroll
              for (int e = 0; e < 4; e++) ov[e] = pack2(res[2 * e], res[2 * e + 1]);
              U4 o; o.x = ov[0]; o.y = ov[1]; o.z = ov[2]; o.w = ov[3];
              if (ch0 < 2048) *(U4*)(XS + (size_t)tt * 2048 + ch0) = o;
              else if (ch0 < 2560) *(U4*)(BM + (size_t)tt * 512 + ch0 - 2048) = o;
              else *(U4*)(CM + (size_t)tt * 512 + ch0 - 2560) = o; }
          }
          for (int it = gw; it < (S_ / 256) * 32; it += nw) { int hh = it & 31, c = it >> 5; float A = -expf(alog[hh]);
            float d[4]; float run = 0;
#pragma unroll
            for (int e = 0; e < 4; e++) { d[e] = DT[(size_t)(c * 256 + lane * 4 + e) * 32 + hh]; }
            float pre[4];
#pragma unroll
            for (int e = 0; e < 4; e++) { run += d[e] * A; pre[e] = run; }
            float sc = run;
#pragma unroll
            for (int dd = 1; dd < 64; dd <<= 1) { float tv = __shfl_up(sc, dd); if (lane >= dd) sc += tv; }
            float excl = sc - run;
            f32x4 dv, cv;
#pragma unroll
            for (int e = 0; e < 4; e++) { dv[e] = d[e]; cv[e] = excl + pre[e]; }
            *(f32x4*)(DTH + (size_t)hh * S_ + c * 256 + lane * 4) = dv; *(f32x4*)(CUMH + (size_t)hh * S_ + c * 256 + lane * 4) = cv; }
        }
        GRID_SYNC(); rederive();
        for (int rs_ = 0; rs_ < NREP(256); rs_++) { const int NC = S_ / 256; const int nCB = NC * 4 * 4, nST = NC * 32;
          for (int it_ = 0, tile; (tile = rmap(it_)) < nCB + nST; it_++) {
            if (tile < nCB) { int ni = tile & 1, mi = (tile >> 1) & 1, g = (tile >> 2) & 3, c = tile >> 4;
              f32x4 acc[4][4]; zero_acc<4, 4>(acc);
              gemm_acc<2, 2, 4, 4, 0, 0, NoAX>(acc, CM + (size_t)(c * 256 + mi * 128) * 512 + g * 128, 512, BM + (size_t)(c * 256 + ni * 128) * 512 + g * 128, 512, 128, smem, NoAX());
              bf16_t* dst = CB + (size_t)(c * 4 + g) * 65536; int m0 = mi * 128 + (wave >> 1) * 64, n0 = ni * 128 + (wave & 1) * 64;
#pragma unroll
              for (int mt = 0; mt < 4; mt++)
#pragma unroll
                for (int nt = 0; nt < 4; nt++)
#pragma unroll
                  for (int j = 0; j < 4; j++) dst[(size_t)(m0 + mt * 16 + quad * 4 + j) * 256 + n0 + nt * 16 + c16] = f2bf(acc[mt][nt][j]);
            } else { int tl = tile - nCB; int hh = tl & 31, c = tl >> 5; int g = hh >> 3;
              const float* dth = DTH + (size_t)hh * S_ + c * 256; const float* cmh = CUMH + (size_t)hh * S_ + c * 256; float cend = cmh[255];
              AXst ax{dth, cmh, cend};
              f32x4 acc[2][4]; zero_acc<2, 4>(acc);
              gemm_acc<2, 2, 2, 4, 1, 1, AXst>(acc, XS + (size_t)(c * 256) * 2048 + hh * 64, 2048, BM + (size_t)(c * 256) * 512 + g * 128, 512, 256, smem, ax);
              bf16_t* dst = ST + (size_t)(c * 32 + hh) * 8192; int m0 = (wave >> 1) * 32, n0 = (wave & 1) * 64;
#pragma unroll
              for (int mt = 0; mt < 2; mt++)
#pragma unroll
                for (int nt = 0; nt < 4; nt++)
#pragma unroll
                  for (int j = 0; j < 4; j++) dst[(size_t)(m0 + mt * 16 + quad * 4 + j) * 128 + n0 + nt * 16 + c16] = f2bf(acc[mt][nt][j]);
            }
          } }
        GRID_SYNC(); rederive();
        { const int NC = S_ / 256;
          constexpr int UB = (S_ / 256) % 8 == 0 ? 8 : 2;
          for (int e = gt; e < 32 * 8192; e += nt_all) { int hh = e >> 13; float run = 0;
            for (int c0 = 0; c0 < NC; c0 += UB) { float cv[UB], ce[UB];
#pragma unroll
              for (int u = 0; u < UB; u++) { cv[u] = bf2f(ST[(size_t)(c0 + u) * 32 * 8192 + e]); ce[u] = CUMH[(size_t)hh * S_ + (c0 + u) * 256 + 255]; }
#pragma unroll
              for (int u = 0; u < UB; u++) { ST[(size_t)(c0 + u) * 32 * 8192 + e] = f2bf(run); run = run * __expf(ce[u]) + cv[u]; } } } }
        GRID_SYNC(); rederive();
        for (int ry_ = NREP(4096) - 1; ry_ >= 0; ry_--) { const int NC = S_ / 256; const float* dsk = as_global(p.in[29]); bf16_t* YD = ry_ ? XR : Z;
          U4 ya1[4], yb1[2], ya2[4], yb2[2];
          auto p1A = [&](int tl) { int mi = tl & 1, hh = (tl >> 1) & 31, c = tl >> 6; return CM + (size_t)(c * 256 + mi * 128) * 512 + (hh >> 3) * 128; };
          auto p1B = [&](int tl) { int hh = (tl >> 1) & 31, c = tl >> 6; return ST + (size_t)(c * 32 + hh) * 8192; };
          if (rmap(0) < NC * 32 * 2) gemm_preload<128, 64, 0, 0>(ya1, yb1, p1A(rmap(0)), 512, p1B(rmap(0)), 128);
          for (int it_ = 0, tile; (tile = rmap(it_)) < NC * 32 * 2; it_++) { int mi = tile & 1, hh = (tile >> 1) & 31, c = tile >> 6; int g = hh >> 3;
            const float* dth = DTH + (size_t)hh * S_ + c * 256; const float* cmh = CUMH + (size_t)hh * S_ + c * 256;
            const bf16_t* A2 = CB + (size_t)(c * 4 + g) * 65536 + (size_t)(mi * 128) * 256; const bf16_t* B2 = XS + (size_t)(c * 256) * 2048 + hh * 64;
            gemm_preload<128, 64, 0, 1>(ya2, yb2, A2, 256, B2, 2048);
            f32x4 acc[4][2]; zero_acc<4, 2>(acc);
            gemm_acc_pre<2, 2, 4, 2, 0, 0, NoAX>(acc, ya1, yb1, p1A(tile), 512, p1B(tile), 128, 128, smem, NoAX());
            int m0 = mi * 128 + (wave >> 1) * 64, n0 = (wave & 1) * 32;
#pragma unroll
            for (int mt = 0; mt < 4; mt++)
#pragma unroll
              for (int j = 0; j < 4; j++) { float e = __expf(cmh[m0 + mt * 16 + quad * 4 + j]); acc[mt][0][j] *= e; acc[mt][1][j] *= e; }
            AXy ax{dth, cmh, mi * 128};
            gemm_acc_pre<2, 2, 4, 2, 0, 1, AXy>(acc, ya2, yb2, A2, 256, B2, 2048, (mi + 1) * 128, smem, ax);
            if (rmap(it_ + 1) < NC * 32 * 2) gemm_preload<128, 64, 0, 0>(ya1, yb1, p1A(rmap(it_ + 1)), 512, p1B(rmap(it_ + 1)), 128);
            float dv = dsk[hh];
#pragma unroll
            for (int mt = 0; mt < 4; mt++)
#pragma unroll
              for (int nt = 0; nt < 2; nt++)
#pragma unroll
                for (int j = 0; j < 4; j++) { size_t o = (size_t)(c * 256 + m0 + mt * 16 + quad * 4 + j) * 2048 + hh * 64 + n0 + nt * 16 + c16;
                  float y = acc[mt][nt][j] + dv * bf2f(XS[o]); y *= siluf_(bf2f(Z[o])); YD[o] = f2bf(y); }
          } }
        GRID_SYNC(); rederive();
        for (int rg_ = NREP(4096) - 1; rg_ >= 0; rg_--) { const float* gn = as_global(p.in[30]); bf16_t* YD = rg_ ? XR : Z;
          for (int it = gw; it < S_ * 4; it += nw) { size_t r = it >> 2; int g = it & 3; bf16_t* yp = Z + r * 2048 + g * 512 + lane * 8;
            U4 q = *(const U4*)yp; float v[8]; float ss = 0;
#pragma unroll
            for (int e = 0; e < 4; e++) { v[2 * e] = bf2f((bf16_t)(q[e] & 0xffff)); v[2 * e + 1] = bf2f((bf16_t)(q[e] >> 16)); }
#pragma unroll
            for (int e = 0; e < 8; e++) ss += v[e] * v[e];
            ss = wave_sum(ss); float rs = rsqrtf(ss * (1.0f / 512.0f) + EPS); const float* gg = gn + g * 512 + lane * 8;
#pragma unroll
            for (int e = 0; e < 4; e++) q[e] = pack2(v[2 * e] * rs * gg[2 * e], v[2 * e + 1] * rs * gg[2 * e + 1]);
            *(U4*)(YD + r * 2048 + g * 512 + lane * 8) = q; } }
        GRID_SYNC(); rederive();
        { float* hb = hbuf + (size_t)bb * S_ * 1024;
          if ((REP) & 2048) gemm_resid(Z, 2048, WB(W_ODOUT), S_, 2048, hb, (float*)(ws + O_XR), smem, bid, nblk);
          gemm_resid(Z, 2048, WB(W_ODOUT), S_, 2048, hb, hb, smem, bid, nblk); }
        GRID_SYNC(); rederive();
      }
    }
    for (int r_ = 0; r_ < NREP(32); r_++) rmsnorm_rows(hbuf, as_global(p.in[32]) + layer * 1024, WB(X_AN), T_, gw, nw);
    if (layer == 0) {
      convert_weight(as_global(p.in[24]), WB(W_ODIN), 1024, ODIN, ODIN_P, false, smem, bid, nblk);
      convert_weight(as_global(p.in[31]), WB(W_ODOUT), 2048, 1024, 1024, false, smem, bid, nblk);
      convert_weight(as_global(p.in[34]) + (size_t)1024 * 512, WB(W_XQ1), 1024, 512, 512, false, smem, bid, nblk);
      convert_weight(as_global(p.in[38]) + (size_t)512 * 1024, WB(W_XO1), 512, 1024, 1024, false, smem, bid, nblk);
      convert_weight(as_global(p.in[40]) + (size_t)1024 * 2 * FH, WB(W_F13_1), 1024, 2 * FH, 2 * FH, true, smem, bid, nblk);
      convert_weight(as_global(p.in[41]) + (size_t)FH * 1024, WB(W_F2_1), FH, 1024, 1024, false, smem, bid, nblk);
    }
    GRID_SYNC(); rederive();
    for (int rq_ = 0; rq_ < NREP(512); rq_++) {
      const bf16_t* Wq = WB(layer ? W_XQ1 : W_XQ0); const float* qh = as_global(p.in[36]) + layer * 128; bf16_t* QX = WB(X_QX);
      for (int it_ = 0, tile; (tile = rmap(it_)) < (T_ / 128) * 4; it_++) { int hh = tile & 3, tm = tile >> 2;
        f32x4 acc[2][8]; zero_acc<2, 8>(acc);
        gemm_acc<4, 1, 2, 8, 0, 0, NoAX>(acc, WB(X_AN) + (size_t)tm * 128 * 1024, 1024, Wq + (size_t)hh * 128 * 1024, 1024, 1024, smem, NoAX());
#pragma unroll
        for (int mt = 0; mt < 2; mt++)
#pragma unroll
          for (int j = 0; j < 4; j++) { size_t t = (size_t)(tm * 128 + wave * 32 + mt * 16 + quad * 4 + j); float ss = 0;
#pragma unroll
            for (int nt = 0; nt < 8; nt++) ss += acc[mt][nt][j] * acc[mt][nt][j];
            ss = sum16(ss); float rs = rsqrtf(ss * (1.0f / 128.0f) + EPS) * (0.08838834764831845f * 1.4426950408889634f);
#pragma unroll
            for (int nt = 0; nt < 8; nt++) QX[t * 512 + hh * 128 + nt * 16 + c16] = f2bf(acc[mt][nt][j] * rs * qh[nt * 16 + c16]); }
      } }
    GRID_SYNC(); rederive();
    for (int ra_ = 0; ra_ < NREP(512); ra_++) { const int nqb = S_ / 64;
      for (int it_ = 0, item; (item = rmap(it_)) < NB * 4 * nqb; it_++) { int qb = item % nqb; int bh = item / nqb; int bb = bh >> 2, hh = bh & 3;
        attn_item<128, 128, false, 1>(WB(X_QX) + (size_t)bb * S_ * 512 + hh * 128, 512, WB(M_KX) + (((size_t)layer * NB + bb) * 4 + hh) * 256 * 128, 128,
                                   WB(M_VXT) + (((size_t)layer * NB + bb) * 4 + hh) * 128 * 256, 256, WB(X_AXO) + (size_t)bb * S_ * 512 + hh * 128, 512, qb * 64, 256, smem); } }
    GRID_SYNC(); rederive();
    if ((REP) & 2048) gemm_resid(WB(X_AXO), 512, WB(layer ? W_XO1 : W_XO0), T_, 512, hbuf, (float*)(ws + X_END), smem, bid, nblk);
    gemm_resid(WB(X_AXO), 512, WB(layer ? W_XO1 : W_XO0), T_, 512, hbuf, hbuf, smem, bid, nblk);
    GRID_SYNC(); rederive();
    for (int r_ = 0; r_ < NREP(32); r_++) rmsnorm_rows(hbuf, as_global(p.in[39]) + layer * 1024, WB(X_AN), T_, gw, nw);
    GRID_SYNC(); rederive();
    for (int rep_ = 0; rep_ < NREP(1); rep_++) { bf16_t* HID = WB(X_HID);
      gemm_phase_128(WB(X_AN), 1024, WB(layer ? W_F13_1 : W_F13_0), T_, 2 * FH, 1024, smem, bid, nblk, [&](f32x4 (&acc)[4][4], int m0, int n0) {
        int hc0 = n0 >> 1;
#pragma unroll
        for (int mt = 0; mt < 4; mt++)
#pragma unroll
          for (int nt = 0; nt < 2; nt++)
#pragma unroll
            for (int j = 0; j < 4; j++) HID[(size_t)(m0 + mt * 16 + quad * 4 + j) * FH + hc0 + nt * 16 + c16] = f2bf(siluf_(acc[mt][nt][j]) * acc[mt][nt + 2][j]);
      }); }
    GRID_SYNC(); rederive();
    if ((REP) & 2048) gemm_resid(WB(X_HID), FH, WB(layer ? W_F2_1 : W_F2_0), T_, FH, hbuf, (float*)(ws + X_END), smem, bid, nblk);
    gemm_resid(WB(X_HID), FH, WB(layer ? W_F2_1 : W_F2_0), T_, FH, hbuf, hbuf, smem, bid, nblk);
    GRID_SYNC(); rederive();
  }
}

extern "C" void kernel_launch(void* const* d_in, const int* in_sizes, int n_in, void* d_out, int out_size, void* d_ws, size_t ws_size, hipStream_t stream) {
  Params p{};
  for (int i = 0; i < 42; i++) p.in[i] = (const GAS float*)d_in[i];
  p.out = (GAS float*)d_out; p.ws = (GAS char*)d_ws;
#ifndef EMU
  static int grid_blocks = 0;
  if (!grid_blocks) {
    int dev = 0, cus = 0, per_cu = 0;
    hipGetDevice(&dev);
    hipDeviceGetAttribute(&cus, hipDeviceAttributeMultiprocessorCount, dev);
    hipFuncSetAttribute((const void*)fwd_megakernel, hipFuncAttributeMaxDynamicSharedMemorySize, SMEM_BYTES);
    hipOccupancyMaxActiveBlocksPerMultiprocessor(&per_cu, fwd_megakernel, NTHR, SMEM_BYTES);
    if (per_cu > 2) per_cu = 2;
    if (per_cu < 1) per_cu = 1;
    grid_blocks = cus * per_cu;
  }
  void* args[] = {&p};
  hipError_t e = hipLaunchCooperativeKernel((const void*)fwd_megakernel, dim3(grid_blocks), dim3(NTHR), args, SMEM_BYTES, stream);
  if (e != hipSuccess) fprintf(stderr, "cooperative launch failed: %s (grid %d)\n", hipGetErrorString(e), grid_blocks);
#else
  emu_launch([&]() { fwd_megakernel(p); }, EMU_GRID, NTHR, SMEM_BYTES);
#endif
}
```

```cpp
#ifndef EMU
#include <hip/hip_runtime.h>
#include <hip/hip_cooperative_groups.h>
#include <cstdio>
namespace cg = cooperative_groups;
typedef short bf16x8 __attribute__((ext_vector_type(8)));
typedef float f32x4 __attribute__((ext_vector_type(4)));
#define CG_SYNC() cg::this_grid().sync()
#define GRID_SYNC() xcd_barrier(xb)
#define MFMA16(a, b, c) __builtin_amdgcn_mfma_f32_16x16x32_bf16((a), (b), (c), 0, 0, 0)
#else
#define CG_SYNC() emu_grid_sync()
#define GRID_SYNC() emu_grid_sync()
#define MFMA16(a, b, c) emu_mfma_bf16((a), (b), (c))
#endif
#include <stdint.h>
#include <stddef.h>
#define DEV __device__ __forceinline__
#ifndef EMU
#define SETPRIO(n) __builtin_amdgcn_s_setprio(n)
#else
#define SETPRIO(n)
#endif
#ifndef EMU
#define GAS __attribute__((address_space(1)))
#else
#define GAS
#endif
#ifndef EMU
#define MEMBAR() asm volatile("" ::: "memory")
#else
#define MEMBAR()
#endif

#ifndef CFG_SEQ
#define CFG_SEQ 16384
#endif
#ifndef CFG_BATCH
#define CFG_BATCH 2
#endif
constexpr int S_ = CFG_SEQ;
constexpr int NB = CFG_BATCH;
constexpr int T_ = S_ * NB;
constexpr int NTHR = 256;
constexpr float EPS = 1e-6f;
#ifndef PM
#define PM 0xffff
#endif
#ifndef REP
#define REP 0
#endif
#ifndef GEMM_SETS
#define GEMM_SETS 1
#endif
#define NREP(bit) (((REP) & (bit)) ? 2 : 1)
constexpr int EVIN = 2464, EVIN_P = 2560, ODIN = 5152, ODIN_P = 5248, FH = 2816;

typedef unsigned short bf16_t;
typedef float f32x2 __attribute__((ext_vector_type(2)));
typedef unsigned U4 __attribute__((ext_vector_type(4)));
typedef unsigned U2 __attribute__((ext_vector_type(2)));

#ifndef EMU
DEV int launder(int v) { asm volatile("" : "+v"(v)); return v; }
#else
DEV int launder(int v) { return v; }
#endif
template <class T> DEV T* as_global(GAS T* q) { return (T*)q; }
#ifndef EMU
template <class T> DEV GAS T* launder_g(GAS T* q) { asm volatile("" : "+s"(q)); return q; }
#else
template <class T> DEV T* launder_g(T* q) { return q; }
#endif
DEV size_t launder_u64(size_t v) {
#ifndef EMU
  asm volatile("" : "+s"(v));
#endif
  return v; }
template <class T> DEV T* launder_sp(T* q) {
#ifndef EMU
  asm volatile("" : "+s"(q));
#endif
  return q; }
DEV bf16_t f2bf(float f) { unsigned u = __float_as_uint(f); u += 0x7fffu + ((u >> 16) & 1u); return (bf16_t)(u >> 16); }
DEV float bf2f(bf16_t h) { return __uint_as_float(((unsigned)h) << 16); }
#ifndef EMU
DEV unsigned pack2(float a, float b) { unsigned r; asm("v_cvt_pk_bf16_f32 %0, %1, %2" : "=v"(r) : "v"(a), "v"(b)); return r; }
DEV float exp2_(float x) { return __builtin_amdgcn_exp2f(x); }
#else
DEV unsigned pack2(float a, float b) { return (unsigned)f2bf(a) | ((unsigned)f2bf(b) << 16); }
DEV float exp2_(float x) { return exp2f(x); }
#endif
#ifndef EMU
DEV float rcp_(float x) { return __builtin_amdgcn_rcpf(x); }
#else
DEV float rcp_(float x) { return 1.0f / x; }
#endif
DEV float sigmoidf_(float x) { return rcp_(1.0f + __expf(-x)); }
DEV float siluf_(float x) { return x * rcp_(1.0f + __expf(-x)); }
#ifdef EMU
#define __logf logf
#endif
DEV float softplusf_(float x) { return fmaxf(x, 0.0f) + __logf(1.0f + __expf(-fabsf(x))); }
DEV float wave_sum(float v) { v += __shfl_xor(v, 32); v += __shfl_xor(v, 16); v += __shfl_xor(v, 8); v += __shfl_xor(v, 4); v += __shfl_xor(v, 2); v += __shfl_xor(v, 1); return v; }
DEV float sum16(float v) { v += __shfl_xor(v, 8); v += __shfl_xor(v, 4); v += __shfl_xor(v, 2); v += __shfl_xor(v, 1); return v; }

struct Params { const GAS float* in[42]; GAS float* out; GAS char* ws; };

constexpr size_t al256(size_t x) { return (x + 255) & ~(size_t)255; }
constexpr size_t W_EVIN = 0;
constexpr size_t W_UQ = W_EVIN + (size_t)EVIN_P * 1024 * 2;
constexpr size_t W_UKV = W_UQ + 768 * 384 * 2;
constexpr size_t W_RW2 = W_UKV + 1024 * 256 * 2;
constexpr size_t W_RA2 = W_RW2 + 512 * 64 * 2;
constexpr size_t W_RG2 = W_RA2 + 512 * 64 * 2;
constexpr size_t W_EVOUT = W_RG2 + 512 * 128 * 2;
constexpr size_t W_XQ0 = W_EVOUT + 1024 * 1024 * 2;
constexpr size_t W_XKV0 = W_XQ0 + 512 * 1024 * 2;
constexpr size_t W_XKV1 = W_XKV0 + 1024 * 1024 * 2;
constexpr size_t W_XO0 = W_XKV1 + 1024 * 1024 * 2;
constexpr size_t W_F13_0 = W_XO0 + 1024 * 512 * 2;
constexpr size_t W_F2_0 = W_F13_0 + (size_t)5632 * 1024 * 2;
constexpr size_t W0_END = W_F2_0 + (size_t)1024 * FH * 2;
constexpr size_t M_MEMN = al256(W0_END);
constexpr size_t M_MEMKV = M_MEMN + (size_t)2 * NB * 256 * 1024 * 2;
constexpr size_t M_KX = M_MEMKV + (size_t)2 * NB * 256 * 1024 * 4;
constexpr size_t M_VXT = M_KX + (size_t)2 * NB * 4 * 256 * 128 * 2;
constexpr size_t M_CNT = M_VXT + (size_t)2 * NB * 4 * 256 * 128 * 2;
constexpr size_t M_BAR = al256(M_CNT + 256);
constexpr size_t DYN0 = al256(M_BAR + 16384);
constexpr size_t W_ODIN = DYN0;
constexpr size_t W_ODOUT = W_ODIN + (size_t)ODIN_P * 1024 * 2;
constexpr size_t W_XQ1 = W_ODOUT + (size_t)1024 * 2048 * 2;
constexpr size_t W_XO1 = W_XQ1 + 512 * 1024 * 2;
constexpr size_t W_F13_1 = W_XO1 + 1024 * 512 * 2;
constexpr size_t W_F2_1 = W_F13_1 + (size_t)5632 * 1024 * 2;
constexpr size_t DYN1 = al256(W_F2_1 + (size_t)1024 * FH * 2);
constexpr size_t TT = (size_t)T_;
constexpr size_t L0_AN = DYN0;
constexpr size_t L0_P0 = L0_AN + TT * 2048;
constexpr size_t L0_QM = L0_P0;
constexpr size_t L0_KM = L0_QM + TT * 768 * 2;
constexpr size_t L0_VMT = L0_KM + TT * 768 * 2;
constexpr size_t L0_ACQ = L0_P0 + TT * EVIN * 2;
constexpr size_t L0_ACKV = L0_ACQ + TT * 384 * 2;
constexpr size_t L0_LW = L0_ACKV + TT * 256 * 2;
constexpr size_t L0_LA = L0_LW + TT * 64 * 2;
constexpr size_t L0_LG = L0_LA + TT * 64 * 2;
constexpr size_t L0_YSC = L0_ACQ;
constexpr size_t L0_KR = L0_LG + TT * 128 * 2;
constexpr size_t L0_SSR = L0_KR + TT * 32 * 4;
constexpr size_t L0_CS = L0_SSR + TT * 4;
constexpr size_t L0_SN = L0_CS + TT * 64;
constexpr size_t L0_KP = L0_SN + TT * 64;
constexpr size_t L0_KK = L0_KP + TT * 1024;
constexpr size_t L0_BV = L0_KK + TT * 1024;
constexpr size_t L0_AMIX = L0_BV + TT * 1024;
constexpr size_t L0_END = L0_AMIX + TT * 2048;
constexpr size_t X_AN = DYN1;
constexpr size_t X_QX = X_AN + TT * 2048;
constexpr size_t X_AXO = X_QX + TT * 1024;
constexpr size_t X_HID = X_AXO + TT * 1024;
constexpr size_t X_END = X_HID + TT * FH * 2;
constexpr size_t SS = (size_t)S_;
constexpr size_t O_Z = X_AN + TT * 2048;
constexpr size_t O_XR = O_Z + SS * 4096;
constexpr size_t O_XS = O_XR + SS * 6144;
constexpr size_t O_BM = O_XS + SS * 4096;
constexpr size_t O_CM = O_BM + SS * 1024;
constexpr size_t O_DT = O_CM + SS * 1024;
constexpr size_t O_DTH = O_DT + SS * 128;
constexpr size_t O_CUMH = O_DTH + SS * 128;
constexpr size_t O_CB = O_CUMH + SS * 128;
constexpr size_t O_ST = O_CB + SS * 2048;
constexpr size_t O_END = O_ST + SS * 2048;
constexpr size_t WS_NEED = (L0_END > X_END ? (L0_END > O_END ? L0_END : O_END) : (X_END > O_END ? X_END : O_END));
static_assert(WS_NEED <= ((size_t)512 << 20), "workspace plan exceeds 512 MiB");
static_assert(L0_LG + TT * 256 - L0_ACQ >= TT * 1024, "YSC fits");

constexpr int LDS_STRIDE = 144;
constexpr int SMEM_BYTES = 2 * (128 + 128) * LDS_STRIDE + 64;

DEV void convert_weight(const float* src, bf16_t* dst, int K, int N, int Npad, bool swiglu, char* smem, int bid, int nblk) {
  float* t = (float*)smem;
  int ntn = Npad / 64, ntk = K / 64, tid = threadIdx.x;
  for (int tile = bid; tile < ntn * ntk; tile += nblk) {
    int n0 = (tile % ntn) * 64, k0 = (tile / ntn) * 64;
    __syncthreads();
    for (int i = 0; i < 16; i++) { int kk = i * 4 + (tid >> 6), nn = tid & 63; int n = n0 + nn; t[kk * 65 + nn] = (n < N) ? src[(size_t)(k0 + kk) * N + n] : 0.0f; }
    __syncthreads();
    for (int i = 0; i < 16; i++) { int nn = i * 4 + (tid >> 6), kk = tid & 63; int n = n0 + nn; int row = n;
      if (swiglu) { int j = (n < FH) ? n : n - FH; row = (j >> 5) * 64 + (j & 31) + ((n < FH) ? 0 : 32); }
      dst[(size_t)row * K + k0 + kk] = f2bf(t[kk * 65 + nn]); }
  }
  __syncthreads();
}

DEV void rmsnorm_rows(const float* src, const float* g, bf16_t* dst, int rows, int gw, int nw) {
  int lane = threadIdx.x & 63;
  for (int r = gw; r < rows; r += nw) {
    const float* p = src + (size_t)r * 1024; float v[16]; float ss = 0;
#pragma unroll
    for (int i = 0; i < 4; i++) { const float4 q = *(const float4*)(p + i * 256 + lane * 4); v[i*4] = q.x; v[i*4+1] = q.y; v[i*4+2] = q.z; v[i*4+3] = q.w; ss += q.x*q.x + q.y*q.y + q.z*q.z + q.w*q.w; }
    ss = wave_sum(ss); float rs = rsqrtf(ss * (1.0f / 1024.0f) + EPS);
#pragma unroll
    for (int i = 0; i < 4; i++) { int c = i * 256 + lane * 4; U2 o; o.x = pack2(v[i*4] * rs * g[c], v[i*4+1] * rs * g[c+1]); o.y = pack2(v[i*4+2] * rs * g[c+2], v[i*4+3] * rs * g[c+3]); *(U2*)(dst + (size_t)r * 1024 + c) = o; }
  }
}

struct NoAX { static constexpr bool ON = false; DEV void chunk0(U4&, int, int) const {} DEV float scale1(int) const { return 1.0f; } };

template <int R, int MODE> DEV void g2r(U4 (&reg)[R / 32], const bf16_t* base, size_t ld, int k0, int tid) {
  const char* bp = (const char*)base; const unsigned ld2 = (unsigned)ld * 2u;
  if (MODE == 0) { const unsigned off0 = (unsigned)(tid >> 3) * ld2 + (unsigned)(tid & 7) * 16u;
#pragma unroll
    for (int i = 0; i < R / 32; i++) { const char* bi = bp + launder_u64((size_t)k0 * 2 + (size_t)i * 32 * ld2); reg[i] = *(const U4*)(bi + off0); } }
  else { constexpr int CPR = R / 8; const unsigned off0 = (unsigned)(tid / CPR) * ld2 + (unsigned)(tid % CPR) * 16u;
#pragma unroll
    for (int i = 0; i < R / 32; i++) { const char* bi = bp + launder_u64((size_t)k0 * ld2 + (size_t)i * (NTHR / CPR) * ld2); reg[i] = *(const U4*)(bi + off0); } }
}
template <int R, int MODE, class AX> DEV void r2s(char* s, U4 (&reg)[R / 32], int k0, int tid, const AX& ax) {
#pragma unroll
  for (int i = 0; i < R / 32; i++) { int c = tid + NTHR * i; U4 v = reg[i];
    if (MODE == 0) { int row = c >> 3, kc = c & 7;
      if (AX::ON) ax.chunk0(v, row, k0 + kc * 8);
      *(U4*)(s + row * LDS_STRIDE + kc * 16) = v; }
    else { int k = c / (R / 8), rc = c % (R / 8);
      float sc1 = AX::ON ? ax.scale1(k0 + k) : 1.0f;
#pragma unroll
      for (int j = 0; j < 8; j++) { bf16_t h = (bf16_t)((v[j >> 1] >> ((j & 1) * 16)) & 0xffff);
        if (AX::ON) h = f2bf(bf2f(h) * sc1);
        *(bf16_t*)(s + (rc * 8 + j) * LDS_STRIDE + k * 2) = h; } } }
}

template <int WGM, int WGN, int WMT, int WNT, int AMODE, int BMODE, class AX>
DEV void gemm_acc(f32x4 (&acc)[WMT][WNT], const bf16_t* A, size_t lda, const bf16_t* B, size_t ldb, int K, char* smem, const AX& ax) {
  constexpr int BM = WGM * WMT * 16, BN = WGN * WNT * 16;
  constexpr int SA = BM * LDS_STRIDE, SB = BN * LDS_STRIDE;
  static_assert(2 * (SA + SB) <= SMEM_BYTES, "LDS");
  char* sA0 = smem; char* sB0 = smem + SA; char* sA1 = smem + SA + SB; char* sB1 = smem + 2 * SA + SB;
  const int tid = launder((int)threadIdx.x), lane = tid & 63, wave = tid >> 6, wm = wave / WGN, wn = wave % WGN;
#if GEMM_SETS == 1
  U4 ra0[BM / 32], rb0[BN / 32];
#else
  U4 ra0[BM / 32], rb0[BN / 32], ra1[BM / 32], rb1[BN / 32];
#endif
  const int nk = K / 64;
  auto compute = [&](const char* cA, const char* cB) {
#pragma unroll
    for (int ks = 0; ks < 2; ks++) {
      bf16x8 bfr[WNT];
      const char* pa = cA + (wm * WMT * 16 + (lane & 15)) * LDS_STRIDE + ks * 64 + (lane >> 4) * 16;
      const char* pb = cB + (wn * WNT * 16 + (lane & 15)) * LDS_STRIDE + ks * 64 + (lane >> 4) * 16;
#pragma unroll
      for (int nt = 0; nt < WNT; nt++) bfr[nt] = *(const bf16x8*)(pb + nt * 16 * LDS_STRIDE);
      SETPRIO(1);
#pragma unroll
      for (int mt = 0; mt < WMT; mt++) { bf16x8 af = *(const bf16x8*)(pa + mt * 16 * LDS_STRIDE);
#pragma unroll
        for (int nt = 0; nt < WNT; nt++) acc[mt][nt] = MFMA16(af, bfr[nt], acc[mt][nt]); }
      SETPRIO(0);
    }
  };
#if GEMM_SETS == 1
  g2r<BM, AMODE>(ra0, A, lda, 0, tid); g2r<BN, BMODE>(rb0, B, ldb, 0, tid);
  __syncthreads();
  r2s<BM, AMODE>(sA0, ra0, 0, tid, ax); r2s<BN, BMODE>(sB0, rb0, 0, tid, NoAX());
  __syncthreads();
#pragma unroll 1
  for (int kt = 0; kt < nk; kt++) {
    char* cA = (kt & 1) ? sA1 : sA0; char* cB = (kt & 1) ? sB1 : sB0;
    char* nA = (kt & 1) ? sA0 : sA1; char* nB = (kt & 1) ? sB0 : sB1;
    if (kt + 1 < nk) { g2r<BM, AMODE>(ra0, A, lda, (kt + 1) * 64, tid); g2r<BN, BMODE>(rb0, B, ldb, (kt + 1) * 64, tid); }
    compute(cA, cB);
    if (kt + 1 < nk) { r2s<BM, AMODE>(nA, ra0, (kt + 1) * 64, tid, ax); r2s<BN, BMODE>(nB, rb0, (kt + 1) * 64, tid, NoAX()); }
    __syncthreads();
  }
}
#else
  g2r<BM, AMODE>(ra0, A, lda, 0, tid); g2r<BN, BMODE>(rb0, B, ldb, 0, tid);
  if (nk > 1) { g2r<BM, AMODE>(ra1, A, lda, 64, tid); g2r<BN, BMODE>(rb1, B, ldb, 64, tid); }
  __syncthreads();
  r2s<BM, AMODE>(sA0, ra0, 0, tid, ax); r2s<BN, BMODE>(sB0, rb0, 0, tid, NoAX());
  if (nk > 2) { g2r<BM, AMODE>(ra0, A, lda, 128, tid); g2r<BN, BMODE>(rb0, B, ldb, 128, tid); }
  __syncthreads();
#pragma unroll 1
  for (int t = 0; t < nk; t += 2) {
    if (t + 1 < nk) { r2s<BM, AMODE>(sA1, ra1, (t + 1) * 64, tid, ax); r2s<BN, BMODE>(sB1, rb1, (t + 1) * 64, tid, NoAX());
      if (t + 3 < nk) { g2r<BM, AMODE>(ra1, A, lda, (t + 3) * 64, tid); g2r<BN, BMODE>(rb1, B, ldb, (t + 3) * 64, tid); } }
    compute(sA0, sB0);
    __syncthreads();
    if (t + 1 >= nk) break;
    if (t + 2 < nk) { r2s<BM, AMODE>(sA0, ra0, (t + 2) * 64, tid, ax); r2s<BN, BMODE>(sB0, rb0, (t + 2) * 64, tid, NoAX());
      if (t + 4 < nk) { g2r<BM, AMODE>(ra0, A, lda, (t + 4) * 64, tid); g2r<BN, BMODE>(rb0, B, ldb, (t + 4) * 64, tid); } }
    compute(sA1, sB1);
    __syncthreads();
  }
}
#endif
template <int BM, int BN, int AMODE, int BMODE> DEV void gemm_preload(U4 (&ra)[BM / 32], U4 (&rb)[BN / 32], const bf16_t* A, size_t lda, const bf16_t* B, size_t ldb) {
  const int tid = launder((int)threadIdx.x); g2r<BM, AMODE>(ra, A, lda, 0, tid); g2r<BN, BMODE>(rb, B, ldb, 0, tid);
}
template <int WGM, int WGN, int WMT, int WNT, int AMODE, int BMODE, class AX>
DEV void gemm_acc_pre(f32x4 (&acc)[WMT][WNT], U4 (&ra0)[WGM * WMT / 2], U4 (&rb0)[WGN * WNT / 2], const bf16_t* A, size_t lda, const bf16_t* B, size_t ldb, int K, char* smem, const AX& ax) {
  constexpr int BM = WGM * WMT * 16, BN = WGN * WNT * 16;
  constexpr int SA = BM * LDS_STRIDE, SB = BN * LDS_STRIDE;
  char* sA0 = smem; char* sB0 = smem + SA; char* sA1 = smem + SA + SB; char* sB1 = smem + 2 * SA + SB;
  const int tid = launder((int)threadIdx.x), lane = tid & 63, wave = tid >> 6, wm = wave / WGN, wn = wave % WGN;
  const int nk = K / 64;
  __syncthreads();
  r2s<BM, AMODE>(sA0, ra0, 0, tid, ax); r2s<BN, BMODE>(sB0, rb0, 0, tid, NoAX());
  __syncthreads();
#pragma unroll 1
  for (int kt = 0; kt < nk; kt++) {
    const char* cA = (kt & 1) ? sA1 : sA0; const char* cB = (kt & 1) ? sB1 : sB0;
    char* nA = (kt & 1) ? sA0 : sA1; char* nB = (kt & 1) ? sB0 : sB1;
    if (kt + 1 < nk) { g2r<BM, AMODE>(ra0, A, lda, (kt + 1) * 64, tid); g2r<BN, BMODE>(rb0, B, ldb, (kt + 1) * 64, tid); }
#pragma unroll
    for (int ks = 0; ks < 2; ks++) {
      bf16x8 bfr[WNT];
      const char* pa = cA + (wm * WMT * 16 + (lane & 15)) * LDS_STRIDE + ks * 64 + (lane >> 4) * 16;
      const char* pb = cB + (wn * WNT * 16 + (lane & 15)) * LDS_STRIDE + ks * 64 + (lane >> 4) * 16;
#pragma unroll
      for (int nt = 0; nt < WNT; nt++) bfr[nt] = *(const bf16x8*)(pb + nt * 16 * LDS_STRIDE);
      SETPRIO(1);
#pragma unroll
      for (int mt = 0; mt < WMT; mt++) { bf16x8 af = *(const bf16x8*)(pa + mt * 16 * LDS_STRIDE);
#pragma unroll
        for (int nt = 0; nt < WNT; nt++) acc[mt][nt] = MFMA16(af, bfr[nt], acc[mt][nt]); }
      SETPRIO(0);
    }
    if (kt + 1 < nk) { r2s<BM, AMODE>(nA, ra0, (kt + 1) * 64, tid, ax); r2s<BN, BMODE>(nB, rb0, (kt + 1) * 64, tid, NoAX()); }
    __syncthreads();
  }
}
template <int WMT, int WNT> DEV void zero_acc(f32x4 (&acc)[WMT][WNT]) {
#pragma unroll
  for (int i = 0; i < WMT; i++)
#pragma unroll
    for (int j = 0; j < WNT; j++) { acc[i][j][0] = 0; acc[i][j][1] = 0; acc[i][j][2] = 0; acc[i][j][3] = 0; }
}

template <class EPI> DEV void gemm_phase_128(const bf16_t* A, size_t lda, const bf16_t* Bt, int M, int Npad, int K, char* smem, int bid, int nblk, EPI epi) {
  const int ntn = Npad / 128, ntm = M / 128; const int tid = launder((int)threadIdx.x), lane = tid & 63, wave = tid >> 6, wm = wave >> 1, wn = wave & 1;
  const int ntiles = ntn * ntm; const bool grouped = ((ntm & 7) == 0) && ((nblk & 7) == 0);
  const int xcd = bid & 7, li = bid >> 3, per = nblk >> 3;
  auto get_tile = [&](int it, int& tm, int& tn) -> bool {
    if (grouped) { int sidx = (it * 8 + xcd) * per + li; if (sidx >= ntiles) return false; int band = sidx / (8 * ntn), sb = sidx % (8 * ntn); tn = sb >> 3; tm = band * 8 + (sb & 7); return true; }
    int tile = bid + it * nblk; if (tile >= ntiles) return false; tn = tile % ntn; tm = tile / ntn; return true; };
  constexpr int SA = 128 * LDS_STRIDE;
  char* sA0 = smem; char* sB0 = smem + SA; char* sA1 = smem + 2 * SA; char* sB1 = smem + 3 * SA;
  const int nk = K / 64;
  U4 ra[4], rb[4];
  int tm = 0, tn = 0; bool have = get_tile(0, tm, tn);
  if (have) { g2r<128, 0>(ra, A + (size_t)tm * 128 * lda, lda, 0, tid); g2r<128, 0>(rb, Bt + (size_t)tn * 128 * K, (size_t)K, 0, tid); }
  for (int it = 0; have; it++) {
    const bf16_t* Ab = A + (size_t)tm * 128 * lda; const bf16_t* Bb = Bt + (size_t)tn * 128 * K;
    f32x4 acc[4][4]; zero_acc<4, 4>(acc);
    __syncthreads();
    r2s<128, 0>(sA0, ra, 0, tid, NoAX()); r2s<128, 0>(sB0, rb, 0, tid, NoAX());
    __syncthreads();
#pragma unroll 1
    for (int kt = 0; kt < nk; kt++) {
      const char* cA = (kt & 1) ? sA1 : sA0; const char* cB = (kt & 1) ? sB1 : sB0;
      char* nA = (kt & 1) ? sA0 : sA1; char* nB = (kt & 1) ? sB0 : sB1;
      if (kt + 1 < nk) { g2r<128, 0>(ra, Ab, lda, (kt + 1) * 64, tid); g2r<128, 0>(rb, Bb, (size_t)K, (kt + 1) * 64, tid); }
#pragma unroll
      for (int ks = 0; ks < 2; ks++) {
        bf16x8 bfr[4];
        const char* pa = cA + (wm * 64 + (lane & 15)) * LDS_STRIDE + ks * 64 + (lane >> 4) * 16;
        const char* pb = cB + (wn * 64 + (lane & 15)) * LDS_STRIDE + ks * 64 + (lane >> 4) * 16;
#pragma unroll
        for (int nt = 0; nt < 4; nt++) bfr[nt] = *(const bf16x8*)(pb + nt * 16 * LDS_STRIDE);
        SETPRIO(1);
#pragma unroll
        for (int mt = 0; mt < 4; mt++) { bf16x8 af = *(const bf16x8*)(pa + mt * 16 * LDS_STRIDE);
#pragma unroll
          for (int nt = 0; nt < 4; nt++) acc[mt][nt] = MFMA16(af, bfr[nt], acc[mt][nt]); }
        SETPRIO(0);
      }
      if (kt + 1 < nk) { r2s<128, 0>(nA, ra, (kt + 1) * 64, tid, NoAX()); r2s<128, 0>(nB, rb, (kt + 1) * 64, tid, NoAX()); }
      __syncthreads();
    }
    const int m0 = tm * 128 + wm * 64, n0 = tn * 128 + wn * 64;
    int tm2 = 0, tn2 = 0; const bool have2 = get_tile(it + 1, tm2, tn2);
    if (have2) { g2r<128, 0>(ra, A + (size_t)tm2 * 128 * lda, lda, 0, tid); g2r<128, 0>(rb, Bt + (size_t)tn2 * 128 * K, (size_t)K, 0, tid); }
    epi(acc, m0, n0);
    tm = tm2; tn = tn2; have = have2;
  }
}

DEV void gemm_resid(const bf16_t* A, size_t lda, const bf16_t* Bt, int M, int K, const float* src, float* dst, char* smem, int bid, int nblk) {
  const int lane = launder((int)threadIdx.x) & 63, c16 = lane & 15, quad = lane >> 4;
  gemm_phase_128(A, lda, Bt, M, 1024, K, smem, bid, nblk, [&](f32x4 (&acc)[4][4], int m0, int n0) {
#pragma unroll
    for (int mt = 0; mt < 4; mt++)
#pragma unroll
      for (int nt = 0; nt < 4; nt++)
#pragma unroll
        for (int j = 0; j < 4; j++) { size_t o = (size_t)(m0 + mt * 16 + quad * 4 + j) * 1024 + n0 + nt * 16 + c16; dst[o] = src[o] + acc[mt][nt][j]; }
  });
}

template <int DK, int DV, bool CAUSAL, int NQ>
DEV void attn_item(const bf16_t* Q, size_t ldq, const bf16_t* Kp, size_t ldk, const bf16_t* VT, size_t ldv, bf16_t* O, size_t ldo, int q0blk, int nkeys, char* smem) {
  constexpr int KS = DK / 32, MV = DV / 16;
  constexpr int KSTR = DK * 2 + 16;
  constexpr int SK = 64 * KSTR, SV = DV * LDS_STRIDE;
  static_assert(2 * (SK + SV) <= SMEM_BYTES, "attn LDS");
  constexpr int KCH = 64 * DK / 8 / NTHR;
  constexpr int VCH = DV * 8 / NTHR;
  const int tid = launder((int)threadIdx.x), lane = tid & 63, wave = tid >> 6, c16 = lane & 15, quad = lane >> 4;
  const int q0 = q0blk + wave * 16 * NQ;
  bf16x8 qf[NQ][KS];
#pragma unroll
  for (int nq = 0; nq < NQ; nq++)
#pragma unroll
    for (int ks = 0; ks < KS; ks++) qf[nq][ks] = *(const bf16x8*)(Q + (size_t)(q0 + nq * 16 + c16) * ldq + ks * 32 + quad * 8);
  f32x4 o[MV][NQ];
#pragma unroll
  for (int i = 0; i < MV; i++)
#pragma unroll
    for (int nq = 0; nq < NQ; nq++) o[i][nq] = f32x4{0, 0, 0, 0};
  float mrun[NQ], lrun[NQ];
#pragma unroll
  for (int nq = 0; nq < NQ; nq++) { mrun[nq] = -INFINITY; lrun[nq] = 0.f; }
  U4 rk[KCH], rv[VCH];
  const int nkt = nkeys / 64;
  auto loadKV = [&](int kt) {
#pragma unroll
    for (int i = 0; i < KCH; i++) { int c = tid + NTHR * i; int row = c / (DK / 8), kc = c % (DK / 8); rk[i] = *(const U4*)(Kp + (size_t)(kt * 64 + row) * ldk + kc * 8); }
#pragma unroll
    for (int i = 0; i < VCH; i++) { int c = tid + NTHR * i; int row = c >> 3, kc = c & 7; rv[i] = *(const U4*)(VT + (size_t)row * ldv + kt * 64 + kc * 8); }
  };
  auto storeKV = [&](char* sk, char* sv) {
#pragma unroll
    for (int i = 0; i < KCH; i++) { int c = tid + NTHR * i; int row = c / (DK / 8), kc = c % (DK / 8); *(U4*)(sk + row * KSTR + kc * 16) = rk[i]; }
#pragma unroll
    for (int i = 0; i < VCH; i++) { int c = tid + NTHR * i; int row = c >> 3, kc = c & 7; *(U4*)(sv + row * LDS_STRIDE + kc * 16) = rv[i]; }
  };
  char* sK0 = smem; char* sV0 = smem + SK; char* sK1 = smem + SK + SV; char* sV1 = smem + 2 * SK + SV;
  loadKV(0);
  __syncthreads();
  storeKV(sK0, sV0);
  __syncthreads();
  for (int kt = 0; kt < nkt; kt++) {
    char* cK = (kt & 1) ? sK1 : sK0; char* cV = (kt & 1) ? sV1 : sV0;
    if (kt + 1 < nkt) loadKV(kt + 1);
    bool active = !CAUSAL || (kt * 64 <= q0 + 16 * NQ - 1);
    if (active) {
      f32x4 s[4][NQ];
#pragma unroll
      for (int mt = 0; mt < 4; mt++)
#pragma unroll
        for (int nq = 0; nq < NQ; nq++) s[mt][nq] = f32x4{0, 0, 0, 0};
#pragma unroll
      for (int ks = 0; ks < KS; ks++)
#pragma unroll
        for (int mt = 0; mt < 4; mt++) { bf16x8 kf = *(const bf16x8*)(cK + (mt * 16 + c16) * KSTR + ks * 64 + quad * 16);

#pragma unroll
          for (int nq = 0; nq < NQ; nq++) s[mt][nq] = MFMA16(kf, qf[nq][ks], s[mt][nq]); }
      bf16x8 pf[NQ][2];
      const bool diag = CAUSAL && (kt * 64 + 63 > q0);
#pragma unroll
      for (int nq = 0; nq < NQ; nq++) {
        int qi = q0 + nq * 16 + c16; float mx = -INFINITY;
#pragma unroll
        for (int mt = 0; mt < 4; mt++)
#pragma unroll
          for (int j = 0; j < 4; j++) { if (CAUSAL && diag) { int key = kt * 64 + mt * 16 + quad * 4 + j; if (key > qi) s[mt][nq][j] = -INFINITY; } mx = fmaxf(mx, s[mt][nq][j]); }
        mx = fmaxf(mx, __shfl_xor(mx, 16)); mx = fmaxf(mx, __shfl_xor(mx, 32));
        float mnew = fmaxf(mrun[nq], mx); float alpha = exp2_(mrun[nq] - mnew); mrun[nq] = mnew;
        float ls = 0;
#pragma unroll
        for (int mt = 0; mt < 4; mt++)
#pragma unroll
          for (int j = 0; j < 4; j++) { float p = exp2_(s[mt][nq][j] - mnew); s[mt][nq][j] = p; ls += p; }
        lrun[nq] = lrun[nq] * alpha + ls;
#pragma unroll
        for (int mv = 0; mv < MV; mv++) { o[mv][nq][0] *= alpha; o[mv][nq][1] *= alpha; o[mv][nq][2] *= alpha; o[mv][nq][3] *= alpha; }
#pragma unroll
        for (int kk = 0; kk < 2; kk++) { U4 pk; pk[0] = pack2(s[2 * kk][nq][0], s[2 * kk][nq][1]); pk[1] = pack2(s[2 * kk][nq][2], s[2 * kk][nq][3]);
          pk[2] = pack2(s[2 * kk + 1][nq][0], s[2 * kk + 1][nq][1]); pk[3] = pack2(s[2 * kk + 1][nq][2], s[2 * kk + 1][nq][3]);
          pf[nq][kk] = __builtin_bit_cast(bf16x8, pk); }
      }
#pragma unroll
      for (int mv = 0; mv < MV; mv++)
#pragma unroll
        for (int kk = 0; kk < 2; kk++) {
          const char* vp = cV + (mv * 16 + c16) * LDS_STRIDE;
          U2 lo = *(const U2*)(vp + (kk * 32 + quad * 4) * 2), hi = *(const U2*)(vp + (kk * 32 + 16 + quad * 4) * 2);
          U4 vv; vv[0] = lo[0]; vv[1] = lo[1]; vv[2] = hi[0]; vv[3] = hi[1]; bf16x8 vf = __builtin_bit_cast(bf16x8, vv);

#pragma unroll
          for (int nq = 0; nq < NQ; nq++) o[mv][nq] = MFMA16(vf, pf[nq][kk], o[mv][nq]); }
    }
    if (kt + 1 < nkt) storeKV((kt & 1) ? sK0 : sK1, (kt & 1) ? sV0 : sV1);
    __syncthreads();
  }
#pragma unroll
  for (int nq = 0; nq < NQ; nq++) {
    float l = lrun[nq]; l += __shfl_xor(l, 16); l += __shfl_xor(l, 32); float inv = 1.0f / l;
    int qi = q0 + nq * 16 + c16;
#pragma unroll
    for (int mv = 0; mv < MV; mv++) { U2 w; w.x = pack2(o[mv][nq][0] * inv, o[mv][nq][1] * inv); w.y = pack2(o[mv][nq][2] * inv, o[mv][nq][3] * inv);
      *(U2*)(O + (size_t)qi * ldo + mv * 16 + quad * 4) = w; }
  }
}

#ifndef EMU
#define DPP_ADD(v, ctrl) ((v) + __builtin_bit_cast(float, __builtin_amdgcn_mov_dpp(__builtin_bit_cast(int, (v)), (ctrl), 0xF, 0xF, true)))
DEV float reduce16(float v) { v = DPP_ADD(v, 0xB1); v = DPP_ADD(v, 0x4E); v = DPP_ADD(v, 0x141); v = DPP_ADD(v, 0x140); return v; }
#else
DEV float reduce16(float v) { v += __shfl_xor(v, 1); v += __shfl_xor(v, 2); v += __shfl_xor(v, 7); v += __shfl_xor(v, 15); return v; }
#endif
DEV void rwkv_scan_worker(const Params& p, int widx, char* smem) {
  const int tid = launder((int)threadIdx.x), lane = tid & 63, wave = tid >> 6;
  const int rg = widx & 7, h = (widx >> 3) & 7, b = widx >> 6;
  const bf16_t* RSH = (const bf16_t*)as_global(p.out); const bf16_t* VSH = RSH + 2 * TT * 512;
  const float* DEC = (const float*)(as_global(p.ws) + L0_AN);
  const bf16_t* KP = (const bf16_t*)(as_global(p.ws) + L0_KP); const bf16_t* KK = (const bf16_t*)(as_global(p.ws) + L0_KK); const bf16_t* BV = (const bf16_t*)(as_global(p.ws) + L0_BV);
  bf16_t* YSC = (bf16_t*)(as_global(p.ws) + L0_YSC);
  constexpr int CH = 16, STEPF = 5 * 64 + 8;
  constexpr int NUNIT = CH * 16 + 4 * CH * 8 + CH;
  constexpr int NSTG = 128; constexpr int NR = (NUNIT + NSTG - 1) / NSTG;
  float* buf0 = (float*)smem; float* buf1 = buf0 + CH * STEPF;
  const size_t tb = (size_t)b * S_;
  const size_t hb = (size_t)h * 64;
  U4 regs[NR];
  auto sload = [&](int ch, int s) {
#pragma unroll
    for (int i = 0; i < NR; i++) { int u = s + NSTG * i; size_t t0 = tb + (size_t)ch * CH;
      if (u < CH * 16) { int tk = u >> 4, q = u & 15; regs[i] = *(const U4*)(DEC + (t0 + tk) * 512 + hb + q * 4); }
      else if (u < CH * 16 + 4 * CH * 8) { int u2 = u - CH * 16; int arr = u2 / (CH * 8), tk = (u2 % (CH * 8)) >> 3, q = u2 & 7;
        const bf16_t* src = (arr == 0) ? KK : (arr == 1) ? BV : (arr == 2) ? KP : RSH; regs[i] = *(const U4*)(src + (t0 + tk) * 512 + hb + q * 8); }
      else if (u < NUNIT) { int tk = u - (CH * 16 + 4 * CH * 8); regs[i] = *(const U4*)(VSH + (t0 + tk) * 512 + hb + rg * 8); } }
  };
  auto sstore = [&](float* buf, int s) {
#pragma unroll
    for (int i = 0; i < NR; i++) { int u = s + NSTG * i; U4 r = regs[i];
      if (u < CH * 16) { int tk = u >> 4, q = u & 15; *(U4*)(buf + tk * STEPF + q * 4) = r; }
      else if (u < NUNIT) {
        f32x4 lo, hi; lo[0] = bf2f((bf16_t)(r[0] & 0xffff)); lo[1] = bf2f((bf16_t)(r[0] >> 16)); lo[2] = bf2f((bf16_t)(r[1] & 0xffff)); lo[3] = bf2f((bf16_t)(r[1] >> 16));
        hi[0] = bf2f((bf16_t)(r[2] & 0xffff)); hi[1] = bf2f((bf16_t)(r[2] >> 16)); hi[2] = bf2f((bf16_t)(r[3] & 0xffff)); hi[3] = bf2f((bf16_t)(r[3] >> 16));
        if (u < CH * 16 + 4 * CH * 8) { int u2 = u - CH * 16; int arr = u2 / (CH * 8), tk = (u2 % (CH * 8)) >> 3, q = u2 & 7; float* dst = buf + tk * STEPF + 64 * (1 + arr) + q * 8;
          if (arr == 0) { lo = -lo; hi = -hi; }
          *(f32x4*)dst = lo; *(f32x4*)(dst + 4) = hi; }
        else { int tk = u - (CH * 16 + 4 * CH * 8); *(f32x4*)(buf + tk * STEPF + 320) = lo; *(f32x4*)(buf + tk * STEPF + 324) = hi; } } }
  };
  __syncthreads();
  if (wave >= 2) { sload(0, tid - 128); sstore(buf0, tid - 128); if (1 < S_ / CH) sload(1, tid - 128); }
  __syncthreads();
  SETPRIO(3);
  f32x2 S01 = {0.f, 0.f}, S23 = {0.f, 0.f};
  const int row = (wave & 1) * 4 + (lane >> 4), part = lane & 15;
  const int nch = S_ / CH;
  for (int ch = 0; ch < nch; ch++) {
    float* cur = (ch & 1) ? buf1 : buf0; float* nxt = (ch & 1) ? buf0 : buf1;
    if (wave >= 2) { if (ch + 1 < nch) { sstore(nxt, tid - 128); if (ch + 2 < nch) sload(ch + 2, tid - 128); } }
    else {
      f32x4 Wq[2], Aq[2], Bq[2], Kq[2], Rq[2]; float Vq[2]; float yv[4];
      { const float* sp = cur + part * 4; Wq[0] = *(const f32x4*)(sp); Aq[0] = *(const f32x4*)(sp + 64); Bq[0] = *(const f32x4*)(sp + 128); Kq[0] = *(const f32x4*)(sp + 192); Rq[0] = *(const f32x4*)(sp + 256); Vq[0] = cur[320 + row]; }
#pragma unroll
      for (int st = 0; st < CH; st++) {
        if (st + 1 < CH) { const float* sp = cur + (st + 1) * STEPF + part * 4; const int n = (st + 1) & 1;
          Wq[n] = *(const f32x4*)(sp); Aq[n] = *(const f32x4*)(sp + 64); Bq[n] = *(const f32x4*)(sp + 128); Kq[n] = *(const f32x4*)(sp + 192); Rq[n] = *(const f32x4*)(sp + 256); Vq[n] = cur[(st + 1) * STEPF + 320 + row]; }
        const int c = st & 1;
        const f32x4 w = Wq[c], a = Aq[c], bb = Bq[c], k = Kq[c], r = Rq[c]; const float vr = Vq[c];
        f32x2 w01 = {w[0], w[1]}, w23 = {w[2], w[3]}, a01 = {a[0], a[1]}, a23 = {a[2], a[3]}, b01 = {bb[0], bb[1]}, b23 = {bb[2], bb[3]};
        f32x2 k01 = {k[0], k[1]}, k23 = {k[2], k[3]}, r01 = {r[0], r[1]}, r23 = {r[2], r[3]};
        f32x2 sp2 = S01 * a01 + S23 * a23;
        float sa = reduce16(sp2[0] + sp2[1]);
        f32x2 sa2 = {sa, sa}, vr2 = {vr, vr};
        S01 = S01 * w01 + (sa2 * b01 + vr2 * k01);
        S23 = S23 * w23 + (sa2 * b23 + vr2 * k23);
        f32x2 yp2 = S01 * r01 + S23 * r23;
        yv[st & 3] = reduce16(yp2[0] + yp2[1]);
        if ((st & 3) == 3) { if (part == 0) { bf16_t* yp = YSC + (tb + (size_t)ch * CH + (st - 3)) * 512 + hb + rg * 8 + row; yp[0] = f2bf(yv[0]); yp[512] = f2bf(yv[1]); yp[1024] = f2bf(yv[2]); yp[1536] = f2bf(yv[3]); } }
      }
    }
    __syncthreads();
  }
  SETPRIO(0);
}

#ifndef EMU
#define XB_TMO      128
#define XB_XCNT(j)  (256  + 64 * (j))
#define XB_XSUB(j)  (1280 + 64 * (j))
#define XB_XGEN(j)  (2304 + 64 * (j))
#define XB_TOP      3328
#define XB_TOPGEN   3392
#define XCD_BAR_WORDS 3456
#define XB_SPIN_CAP (1u << 18)
#define LAS __attribute__((address_space(3)))

__device__ __forceinline__ unsigned xb_ld(unsigned* p)              { return __hip_atomic_load(p, __ATOMIC_RELAXED, __HIP_MEMORY_SCOPE_AGENT); }
__device__ __forceinline__ unsigned xb_add(unsigned* p, unsigned v) { return __hip_atomic_fetch_add(p, v, __ATOMIC_RELAXED, __HIP_MEMORY_SCOPE_AGENT); }
__device__ __forceinline__ unsigned xb_xcc_id() { return (unsigned)__builtin_amdgcn_s_getreg((3 << 11) | 20) & 0xFu; }
#define XB_SPIN(cond, bar) do { unsigned _sp = 0; while (cond) { __builtin_amdgcn_s_sleep(1); \
    if ((++_sp & 255u) == 0u) { if (xb_ld(&(bar)[XB_TMO])) break; if (_sp > XB_SPIN_CAP) { atomicAdd(&(bar)[XB_TMO], 1u); break; } } } } while (0)

struct XcdBarrier {
    unsigned* bar; unsigned x;
    volatile LAS unsigned* st;
};

__device__ __forceinline__ XcdBarrier xcd_barrier_post(unsigned* bar, volatile LAS unsigned* st) {
    XcdBarrier b; b.bar = bar; b.x = xb_xcc_id(); b.st = st;
    if (threadIdx.x == 0) (void)xb_add(&bar[XB_XCNT(b.x)], 1u);
    return b;
}
__device__ __forceinline__ void xcd_barrier_complete(unsigned* bar, unsigned x, unsigned& nloc, unsigned& nx) {
    const unsigned G = gridDim.x * gridDim.y * gridDim.z;
    unsigned sum, cnt, mine, sp = 0u;
    for (;;) {
        sum = 0u; cnt = 0u; mine = 0u;
#pragma unroll
        for (unsigned j = 0; j < 16; ++j) { const unsigned c = xb_ld(&bar[XB_XCNT(j)]); sum += c; cnt += (c > 0u) ? 1u : 0u; mine = (j == x) ? c : mine; }
        if (sum == G) break;
        __builtin_amdgcn_s_sleep(1);
        if ((++sp & 255u) == 0u) { if (xb_ld(&bar[XB_TMO])) break; if (sp > XB_SPIN_CAP) { atomicAdd(&bar[XB_TMO], 1u); break; } }
    }
    nloc = mine > 0u ? mine : 1u; nx = cnt > 0u ? cnt : 1u;
}

__device__ __forceinline__ void xcd_barrier(const XcdBarrier& b) {
    asm volatile("s_waitcnt vmcnt(0)" ::: "memory");
    __syncthreads();
    if (threadIdx.x == 0) {
        unsigned* bar = b.bar;
        __builtin_amdgcn_s_waitcnt(0);
        unsigned nloc = b.st[0], nx = b.st[1];
        if (nloc == 0u) { xcd_barrier_complete(bar, b.x, nloc, nx); b.st[0] = nloc; b.st[1] = nx; }
        const unsigned old = xb_add(&bar[XB_XSUB(b.x)], 1u);
        const unsigned gen = old / nloc;
        if (old + 1u == (gen + 1u) * nloc) {
            __builtin_amdgcn_fence(__ATOMIC_RELEASE, "agent");
            asm volatile("s_waitcnt vmcnt(0)" ::: "memory");
            const unsigned og = xb_add(&bar[XB_TOP], 1u);
            const unsigned tg = og / nx;
            if (og + 1u == (tg + 1u) * nx) xb_add(&bar[XB_TOPGEN], 1u);
            else XB_SPIN(xb_ld(&bar[XB_TOPGEN]) == tg, bar);
            __builtin_amdgcn_fence(__ATOMIC_ACQUIRE, "agent");
            xb_add(&bar[XB_XGEN(b.x)], 1u);
            asm volatile("s_waitcnt vmcnt(0)" ::: "memory");
        } else {
            XB_SPIN(xb_ld(&bar[XB_XGEN(b.x)]) == gen, bar);
            __builtin_amdgcn_fence(__ATOMIC_ACQUIRE, "agent");
            asm volatile("s_waitcnt vmcnt(0)" ::: "memory");
        }
    }
    __syncthreads();
}

#endif
struct AXst { const float* dth; const float* cmh; float cend; static constexpr bool ON = true;
  DEV void chunk0(U4&, int, int) const {}
  DEV float scale1(int k) const { return dth[k] * __expf(cend - cmh[k]); } };
struct AXy { const float* dth; const float* cmh; int l0; static constexpr bool ON = true;
  DEV float scale1(int) const { return 1.0f; }
  DEV void chunk0(U4& v, int m, int k) const { const int l = l0 + m; const float cl = cmh[l];
    const f32x4 c0 = *(const f32x4*)(cmh + k), c1 = *(const f32x4*)(cmh + k + 4), d0 = *(const f32x4*)(dth + k), d1 = *(const f32x4*)(dth + k + 4);
#pragma unroll
    for (int j = 0; j < 4; j++) { const float ca = (j < 2) ? c0[2 * j] : c1[2 * j - 4], cb = (j < 2) ? c0[2 * j + 1] : c1[2 * j - 3];
      const float da = (j < 2) ? d0[2 * j] : d1[2 * j - 4], db = (j < 2) ? d0[2 * j + 1] : d1[2 * j - 3];
      float a = bf2f((bf16_t)(v[j] & 0xffff)), b = bf2f((bf16_t)(v[j] >> 16));
      a = (k + 2 * j <= l) ? a * __expf(cl - ca) * da : 0.f; b = (k + 2 * j + 1 <= l) ? b * __expf(cl - cb) * db : 0.f;
      v[j] = pack2(a, b); } } };
__global__ void __launch_bounds__(NTHR, 2) fwd_megakernel(Params p) {
#ifndef EMU
  extern __shared__ __attribute__((aligned(16))) char smem_[];
  char* smem = smem_;
#else
  char* smem = emu_cur->blk->smem;
#endif
  int tid = threadIdx.x, lane = tid & 63, wave = tid >> 6, c16 = lane & 15, quad = lane >> 4;
  const int bid = blockIdx.x, nblk = gridDim.x;
  int gw = bid * 4 + wave; const int nw = nblk * 4;
  int gt = bid * NTHR + tid; const int nt_all = nblk * NTHR;
  GAS char* wsg = p.ws; GAS float* hbg = p.out;
  char* ws = as_global(wsg);
  const float* x = as_global(p.in[0]); const float* mem = as_global(p.in[1]); const int* pos = (const int*)as_global(p.in[2]);
  float* hbuf = as_global(hbg);
  auto rederive = [&]() { tid = launder(tid); lane = tid & 63; wave = tid >> 6; c16 = lane & 15; quad = lane >> 4; gw = bid * 4 + wave; gt = bid * NTHR + tid; wsg = launder_g(wsg); hbg = launder_g(hbg); ws = as_global(wsg); hbuf = as_global(hbg); };
  auto rmap = [&](int it) { return ((nblk & 7) == 0) ? ((it * 8 + (bid & 7)) * (nblk >> 3) + (bid >> 3)) : (bid + it * nblk); };
  int* cnt = (int*)(ws + M_CNT);
  auto WB = [&](size_t off) { return (bf16_t*)(ws + off); };

#ifndef EMU
  volatile LAS unsigned* xst = (volatile LAS unsigned*)(smem + SMEM_BYTES - 48);
  unsigned* xbar = (unsigned*)(ws + M_BAR);
  if (tid == 0) { xst[0] = 0u; xst[1] = 0u; }
  if (bid == 0) for (int i = tid; i < XCD_BAR_WORDS; i += NTHR) xbar[i] = 0u;
#endif
  for (int rep0_ = 0; rep0_ < NREP(4); rep0_++) {
  convert_weight(as_global(p.in[4]), WB(W_EVIN), 1024, EVIN, EVIN_P, false, smem, bid, nblk);
  convert_weight(as_global(p.in[6]), WB(W_UQ), 384, 768, 768, false, smem, bid, nblk);
  convert_weight(as_global(p.in[8]), WB(W_UKV), 256, 1024, 1024, false, smem, bid, nblk);
  convert_weight(as_global(p.in[13]), WB(W_RW2), 64, 512, 512, false, smem, bid, nblk);
  convert_weight(as_global(p.in[15]), WB(W_RA2), 64, 512, 512, false, smem, bid, nblk);
  convert_weight(as_global(p.in[16]), WB(W_RG2), 128, 512, 512, false, smem, bid, nblk);
  convert_weight(as_global(p.in[22]), WB(W_EVOUT), 1024, 1024, 1024, false, smem, bid, nblk);
  convert_weight(as_global(p.in[34]), WB(W_XQ0), 1024, 512, 512, false, smem, bid, nblk);
  convert_weight(as_global(p.in[35]), WB(W_XKV0), 1024, 1024, 1024, false, smem, bid, nblk);
  convert_weight(as_global(p.in[35]) + (size_t)1024 * 1024, WB(W_XKV1), 1024, 1024, 1024, false, smem, bid, nblk);
  convert_weight(as_global(p.in[38]), WB(W_XO0), 512, 1024, 1024, false, smem, bid, nblk);
  convert_weight(as_global(p.in[40]), WB(W_F13_0), 1024, 2 * FH, 2 * FH, true, smem, bid, nblk);
  convert_weight(as_global(p.in[41]), WB(W_F2_0), FH, 1024, 1024, false, smem, bid, nblk);
  rmsnorm_rows(x, as_global(p.in[3]), WB(L0_AN), T_, gw, nw);
  rmsnorm_rows(mem, as_global(p.in[33]), WB(M_MEMN), NB * 256, gw, nw);
  rmsnorm_rows(mem, as_global(p.in[33]) + 1024, WB(M_MEMN) + (size_t)NB * 256 * 1024, NB * 256, gw, nw);
  }
  if (gt < 16) cnt[gt] = 0;
  CG_SYNC(); rederive();
#ifndef EMU
  XcdBarrier xb = xcd_barrier_post(xbar, xst);
#endif

  for (int rep1_ = 0; rep1_ < NREP(64); rep1_++) {
    bf16_t* P0 = WB(L0_P0);
    gemm_phase_128(WB(L0_AN), 1024, WB(W_EVIN), T_, EVIN_P, 1024, smem, bid, nblk, [&](f32x4 (&acc)[4][4], int m0, int n0) {
#pragma unroll
      for (int mt = 0; mt < 4; mt++)
#pragma unroll
        for (int nt = 0; nt < 4; nt++) { int col = n0 + nt * 16 + c16; if (col < EVIN) {
#pragma unroll
          for (int j = 0; j < 4; j++) P0[(size_t)(m0 + mt * 16 + quad * 4 + j) * EVIN + col] = f2bf(acc[mt][nt][j]); } }
    });
    for (int i = 0; i < 2; i++) {
      float* KV = (float*)(ws + M_MEMKV) + (size_t)i * NB * 256 * 1024;
      gemm_phase_128(WB(M_MEMN) + (size_t)i * NB * 256 * 1024, 1024, WB(i ? W_XKV1 : W_XKV0), NB * 256, 1024, 1024, smem, bid, nblk, [&](f32x4 (&acc)[4][4], int m0, int n0) {
#pragma unroll
        for (int mt = 0; mt < 4; mt++)
#pragma unroll
          for (int nt = 0; nt < 4; nt++)
#pragma unroll
            for (int j = 0; j < 4; j++) KV[(size_t)(m0 + mt * 16 + quad * 4 + j) * 1024 + n0 + nt * 16 + c16] = acc[mt][nt][j];
      });
    }
  }
  GRID_SYNC(); rederive();

  for (int rep2_ = 0; rep2_ < NREP(8); rep2_++) {
    const bf16_t* P0 = WB(L0_P0);
    bf16_t* ACQ = WB(L0_ACQ); bf16_t* ACKV = WB(L0_ACKV); bf16_t* LW = WB(L0_LW); bf16_t* LA = WB(L0_LA); bf16_t* LG = WB(L0_LG);
    float* KR = (float*)(ws + L0_KR); float* SSR = (float*)(ws + L0_SSR);
    bf16_t* RSH = (bf16_t*)as_global(p.out); bf16_t* KSH = RSH + TT * 512; bf16_t* VSH = RSH + 2 * TT * 512;
    const float* qn = as_global(p.in[5]); const float* kvn = as_global(p.in[7]); const float* khn = as_global(p.in[10]); const float* mu = as_global(p.in[11]);
    const float invf_lane = powf(10000.0f, -(float)(lane & 15) / 16.0f);
    for (int t = gw; t < T_; t += nw) {
      const bf16_t* pr = P0 + (size_t)t * EVIN; int s = t % S_;
      float v[6]; float ss = 0;
#pragma unroll
      for (int i = 0; i < 6; i++) { v[i] = bf2f(pr[lane + 64 * i]); ss += v[i] * v[i]; }
      ss = wave_sum(ss); float rs = rsqrtf(ss * (1.0f / 384.0f) + EPS);
#pragma unroll
      for (int i = 0; i < 6; i++) ACQ[(size_t)t * 384 + lane + 64 * i] = f2bf(v[i] * rs * qn[lane + 64 * i]);
      ss = 0;
#pragma unroll
      for (int i = 0; i < 4; i++) { v[i] = bf2f(pr[384 + lane + 64 * i]); ss += v[i] * v[i]; }
      ss = wave_sum(ss); rs = rsqrtf(ss * (1.0f / 256.0f) + EPS);
#pragma unroll
      for (int i = 0; i < 4; i++) ACKV[(size_t)t * 256 + lane + 64 * i] = f2bf(v[i] * rs * kvn[lane + 64 * i]);
      float kr = (lane < 32) ? bf2f(pr[640 + lane]) : 0.f;
      float ssr = wave_sum(kr * kr);
      float xg = kr * ((lane < 32) ? khn[64 + lane] : 0.f);
      float other = __shfl_xor(xg, 16);
      float ang = (float)pos[t] * invf_lane;
      float cs = cosf(ang), sn = sinf(ang);
      float ro = (lane & 16) ? (xg * cs + other * sn) : (xg * cs - other * sn);
      if (lane < 32) KR[(size_t)t * 32 + lane] = ro;
      if (lane == 0) SSR[t] = ssr;
      if (lane < 16) { ((float*)(ws + L0_CS))[(size_t)t * 16 + lane] = cs; ((float*)(ws + L0_SN))[(size_t)t * 16 + lane] = sn; }
#pragma unroll 4
      for (int i = 0; i < 28; i++) { int j = lane + 64 * i; float cur = bf2f(pr[672 + j]); float prev = (s == 0) ? 0.f : bf2f(pr[672 + j - EVIN]);
        float pv = cur + (prev - cur) * mu[j];
        if (i < 8) RSH[(size_t)t * 512 + j] = f2bf(pv);
        else if (i < 16) KSH[(size_t)t * 512 + j - 512] = f2bf(pv);
        else if (i < 24) VSH[(size_t)t * 512 + j - 1024] = f2bf(pv);
        else if (i < 25) LW[(size_t)t * 64 + j - 1536] = f2bf(1.0f - 2.0f * rcp_(1.0f + __expf(2.0f * pv)));
        else if (i < 26) LA[(size_t)t * 64 + j - 1600] = f2bf(pv);
        else LG[(size_t)t * 128 + j - 1664] = f2bf(sigmoidf_(pv)); }
    }
    for (int it = gw; it < 2 * NB * 256 * 4; it += nw) {
      int hh = it & 3, m = (it >> 2) % (NB * 256), li = it / (NB * 256 * 4); int bb = m / 256, mm = m % 256;
      const float* kvrow = (const float*)(ws + M_MEMKV) + ((size_t)li * NB * 256 + m) * 1024;
      float k0 = kvrow[hh * 128 + lane], k1 = kvrow[hh * 128 + 64 + lane];
      float ss = wave_sum(k0 * k0 + k1 * k1); float rs = rsqrtf(ss * (1.0f / 128.0f) + EPS);
      const float* kg = as_global(p.in[37]) + li * 128;
      bf16_t* KX = WB(M_KX) + (((size_t)li * NB + bb) * 4 + hh) * 256 * 128;
      KX[mm * 128 + lane] = f2bf(k0 * rs * kg[lane]); KX[mm * 128 + 64 + lane] = f2bf(k1 * rs * kg[64 + lane]);
      bf16_t* VX = WB(M_VXT) + (((size_t)li * NB + bb) * 4 + hh) * 128 * 256;
      VX[lane * 256 + mm] = f2bf(kvrow[512 + hh * 128 + lane]); VX[(64 + lane) * 256 + mm] = f2bf(kvrow[512 + hh * 128 + 64 + lane]);
    }
  }
  GRID_SYNC(); rederive();

  for (int rep3_ = 0; rep3_ < NREP(128); rep3_++) {
    const int MT = T_ / 128;
    const int nQ = MT * 8, nKV = MT * 8, nW = MT * 4, nA = MT * 4, nG = MT * 4;
    const float* SSR = (const float*)(ws + L0_SSR); const float* KR = (const float*)(ws + L0_KR);
    for (int it_ = 0, tile; (tile = rmap(it_)) < nQ + nKV + nW + nA + nG; it_++) {
      if (!(PM & 2)) break;
      if (tile < nQ) {
        int hh = tile % 8, tm = tile / 8;
        f32x4 acc[2][6]; zero_acc<2, 6>(acc);
        gemm_acc<4, 1, 2, 6, 0, 0, NoAX>(acc, WB(L0_ACQ) + (size_t)tm * 128 * 384, 384, WB(W_UQ) + (size_t)hh * 96 * 384, 384, 384, smem, NoAX());
        const float* qh = as_global(p.in[9]); bf16_t* QM = WB(L0_QM);
        const float* CSb = (const float*)(ws + L0_CS); const float* SNb = (const float*)(ws + L0_SN);
#pragma unroll
        for (int mt = 0; mt < 2; mt++)
#pragma unroll
          for (int j = 0; j < 4; j++) { int t = tm * 128 + wave * 32 + mt * 16 + quad * 4 + j; float ss = 0;
#pragma unroll
            for (int nt = 0; nt < 6; nt++) ss += acc[mt][nt][j] * acc[mt][nt][j];
            ss = sum16(ss); float rs = rsqrtf(ss * (1.0f / 96.0f) + EPS);
            float vals[6];
#pragma unroll
            for (int nt = 0; nt < 6; nt++) vals[nt] = acc[mt][nt][j] * rs * qh[nt * 16 + c16];
            float cs = CSb[(size_t)t * 16 + c16], sn = SNb[(size_t)t * 16 + c16];
            float x1 = vals[4], x2 = vals[5]; vals[4] = x1 * cs - x2 * sn; vals[5] = x2 * cs + x1 * sn;
            int bb = t / S_, s = t % S_; bf16_t* dst = QM + ((size_t)(bb * 8 + hh) * S_ + s) * 96;
            const float scale = 0.10206207261596577f * 1.4426950408889634f;
#pragma unroll
            for (int nt = 0; nt < 6; nt++) dst[nt * 16 + c16] = f2bf(vals[nt] * scale);
            MEMBAR(); }
      } else if (tile < nQ + nKV) {
        int tl = tile - nQ; int hh = tl % 8, tm = tl / 8;
        f32x4 acc[2][8]; zero_acc<2, 8>(acc);
        gemm_acc<4, 1, 2, 8, 0, 0, NoAX>(acc, WB(L0_ACKV) + (size_t)tm * 128 * 256, 256, WB(W_UKV) + (size_t)hh * 128 * 256, 256, 256, smem, NoAX());
        const float* kh = as_global(p.in[10]); bf16_t* KM = WB(L0_KM); bf16_t* VMT = WB(L0_VMT);
#pragma unroll
        for (int mt = 0; mt < 2; mt++) {
          int tbase = tm * 128 + wave * 32 + mt * 16 + quad * 4; int bb = tbase / S_, s0 = tbase % S_;
#pragma unroll
          for (int j = 0; j < 4; j++) { int t = tbase + j; float ss = 0;
#pragma unroll
            for (int nt = 0; nt < 4; nt++) ss += acc[mt][nt][j] * acc[mt][nt][j];
            ss = sum16(ss) + SSR[t]; float rs = rsqrtf(ss * (1.0f / 96.0f) + EPS);
            bf16_t* dst = KM + ((size_t)(bb * 8 + hh) * S_ + s0 + j) * 96;
#pragma unroll
            for (int nt = 0; nt < 4; nt++) dst[nt * 16 + c16] = f2bf(acc[mt][nt][j] * rs * kh[nt * 16 + c16]);
            dst[64 + c16] = f2bf(rs * KR[(size_t)t * 32 + c16]); dst[80 + c16] = f2bf(rs * KR[(size_t)t * 32 + 16 + c16]); MEMBAR(); }
#pragma unroll
          for (int nt = 4; nt < 8; nt++) { U2 w; w.x = pack2(acc[mt][nt][0], acc[mt][nt][1]); w.y = pack2(acc[mt][nt][2], acc[mt][nt][3]);
            *(U2*)(VMT + ((size_t)(bb * 8 + hh) * 64 + (nt - 4) * 16 + c16) * S_ + s0) = w; }
        }
      } else {
        int tl = tile - nQ - nKV; int which = tl / nW; tl %= nW; int tn = tl % 4, tm = tl / 4;
        f32x4 acc[4][4]; zero_acc<4, 4>(acc);
        int m0 = tm * 128 + (wave >> 1) * 64, n0 = tn * 128 + (wave & 1) * 64;
        if (which == 0) {
          gemm_acc<2, 2, 4, 4, 0, 0, NoAX>(acc, WB(L0_LW) + (size_t)tm * 128 * 64, 64, WB(W_RW2) + (size_t)tn * 128 * 64, 64, 64, smem, NoAX());
          float* DEC = (float*)(ws + L0_AN); const float* w0 = as_global(p.in[12]);
#pragma unroll
          for (int mt = 0; mt < 4; mt++)
#pragma unroll
            for (int nt = 0; nt < 4; nt++) { int col = n0 + nt * 16 + c16;
#pragma unroll
              for (int j = 0; j < 4; j++) { float z = w0[col] + acc[mt][nt][j]; float wl = -softplusf_(-z) - 0.5f; DEC[(size_t)(m0 + mt * 16 + quad * 4 + j) * 512 + col] = __expf(-__expf(wl)); } }
        } else if (which == 1) {
          gemm_acc<2, 2, 4, 4, 0, 0, NoAX>(acc, WB(L0_LA) + (size_t)tm * 128 * 64, 64, WB(W_RA2) + (size_t)tn * 128 * 64, 64, 64, smem, NoAX());
          const bf16_t* KSH = (const bf16_t*)as_global(p.out) + TT * 512; const float* a0 = as_global(p.in[14]); const float* k_k = as_global(p.in[17]); const float* k_a = as_global(p.in[18]);
          bf16_t* KP = WB(L0_KP); bf16_t* KK = WB(L0_KK); bf16_t* BV = WB(L0_BV);
#pragma unroll
          for (int mt = 0; mt < 4; mt++)
#pragma unroll
            for (int j = 0; j < 4; j++) { size_t t = (size_t)(m0 + mt * 16 + quad * 4 + j); float kv[4], kkv[4]; float ss = 0;
#pragma unroll
              for (int nt = 0; nt < 4; nt++) { int col = n0 + nt * 16 + c16; kv[nt] = bf2f(KSH[t * 512 + col]); kkv[nt] = kv[nt] * k_k[col]; ss += kkv[nt] * kkv[nt]; }
              ss = sum16(ss); float inv = 1.0f / fmaxf(sqrtf(ss), 1e-12f);
#pragma unroll
              for (int nt = 0; nt < 4; nt++) { int col = n0 + nt * 16 + c16; float a = sigmoidf_(a0[col] + acc[mt][nt][j]); float kk = kkv[nt] * inv;
                KP[t * 512 + col] = f2bf(kv[nt] * (1.0f + (a - 1.0f) * k_a[col])); KK[t * 512 + col] = f2bf(kk); BV[t * 512 + col] = f2bf(kk * a); }
              MEMBAR(); }
        } else {
          gemm_acc<2, 2, 4, 4, 0, 0, NoAX>(acc, WB(L0_LG) + (size_t)tm * 128 * 128, 128, WB(W_RG2) + (size_t)tn * 128 * 128, 128, 128, smem, NoAX());
          bf16_t* G = (bf16_t*)as_global(p.out) + 3 * TT * 512;
#pragma unroll
          for (int mt = 0; mt < 4; mt++)
#pragma unroll
            for (int nt = 0; nt < 4; nt++)
#pragma unroll
              for (int j = 0; j < 4; j++) G[(size_t)(m0 + mt * 16 + quad * 4 + j) * 512 + n0 + nt * 16 + c16] = f2bf(acc[mt][nt][j]);
        }
      }
    }
  }
  GRID_SYNC(); rederive();

  for (int rep_ = 0; rep_ < NREP(2); rep_++) {
    const int nscan = NB * 64, nqb = S_ / 128, nattn = NB * 8 * nqb;
    int* sitem = (int*)(smem + SMEM_BYTES - 16);
    for (;;) {
      __syncthreads();
      if (tid == 0) *sitem = atomicAdd(&cnt[rep_], 1);
      __syncthreads();
      int item = *sitem;
      if (item >= nscan + nattn) break;
      if (item < nscan) { if (PM & 4) rwkv_scan_worker(p, item, smem); }
      else if (PM & 8) { int a = item - nscan; int qb = nqb - 1 - a / (NB * 8); int bh = a % (NB * 8); int bb = bh / 8, hh = bh % 8;
        attn_item<96, 64, true, 2>(WB(L0_QM) + (size_t)bh * S_ * 96, 96, WB(L0_KM) + (size_t)bh * S_ * 96, 96, WB(L0_VMT) + (size_t)bh * 64 * S_, (size_t)S_,
                                WB(L0_AMIX) + (size_t)bb * S_ * 1024 + hh * 64, 1024, qb * 128, (qb + 1) * 128, smem); }
    }
  }
  GRID_SYNC(); rederive();

  for (int rep6_ = 0; rep6_ < NREP(16); rep6_++) {
    const bf16_t* YSC = WB(L0_YSC); const bf16_t* RSH = (const bf16_t*)as_global(p.out); const bf16_t* VSH = RSH + 2 * TT * 512; const bf16_t* G = RSH + 3 * TT * 512;
    const bf16_t* KP = WB(L0_KP); bf16_t* AMIX = WB(L0_AMIX);
    const float* r_k = as_global(p.in[19]); const float* ln_g = as_global(p.in[20]); const float* ln_b = as_global(p.in[21]);
    for (int it = gw; it < T_ * 8; it += nw) { size_t t = it >> 3; int hh = it & 7; size_t idx = t * 512 + hh * 64 + lane; int ch = hh * 64 + lane;
      float y = bf2f(YSC[idx]); float mean = wave_sum(y) * (1.0f / 64.0f); float d = y - mean; float var = wave_sum(d * d) * (1.0f / 64.0f);
      float yn = d * rsqrtf(var + 64e-5f) * ln_g[ch] + ln_b[ch];
      float r = bf2f(RSH[idx]), k = bf2f(KP[idx]), v = bf2f(VSH[idx]);
      float bon = wave_sum(r * k * r_k[ch]) * v;
      AMIX[t * 1024 + 512 + ch] = f2bf((yn + bon) * bf2f(G[idx])); }
  }
  GRID_SYNC(); rederive();

  for (int r_ = 0; r_ < NREP(2048); r_++) gemm_resid(WB(L0_AMIX), 1024, WB(W_EVOUT), T_, 1024, x, hbuf, smem, bid, nblk);
  GRID_SYNC(); rederive();

#pragma unroll
  for (int layer = 0; layer < 2; layer++) {
    if (layer == 1 && (PM & 32)) {
      for (int r_ = 0; r_ < NREP(32); r_++) rmsnorm_rows(hbuf, as_global(p.in[23]), WB(X_AN), T_, gw, nw);
      GRID_SYNC(); rederive();
      for (int bb = 0; bb < NB; bb++) {
        bf16_t* Z = WB(O_Z); bf16_t* XR = WB(O_XR); bf16_t* XS = WB(O_XS); bf16_t* BM = WB(O_BM); bf16_t* CM = WB(O_CM);
        float* DT = (float*)(ws + O_DT); float* DTH = (float*)(ws + O_DTH); float* CUMH = (float*)(ws + O_CUMH);
        bf16_t* CB = WB(O_CB); bf16_t* ST = WB(O_ST);
        for (int ri_ = 0; ri_ < NREP(256); ri_++) { const float* dtb = as_global(p.in[27]);
          gemm_phase_128(WB(X_AN) + (size_t)bb * S_ * 1024, 1024, WB(W_ODIN), S_, ODIN_P, 1024, smem, bid, nblk, [&](f32x4 (&acc)[4][4], int m0, int n0) {
#pragma unroll
            for (int mt = 0; mt < 4; mt++)
#pragma unroll
              for (int nt = 0; nt < 4; nt++) { int col = n0 + nt * 16 + c16;
#pragma unroll
                for (int j = 0; j < 4; j++) { size_t r = (size_t)(m0 + mt * 16 + quad * 4 + j); float v = acc[mt][nt][j];
                  if (col < 2048) Z[r * 2048 + col] = f2bf(v);
                  else if (col < 5120) XR[r * 3072 + col - 2048] = f2bf(v);
                  else if (col < ODIN) DT[r * 32 + col - 5120] = softplusf_(v + dtb[col - 5120]); } }
          }); }
        GRID_SYNC(); rederive();
        for (int rc_ = 0; rc_ < NREP(256); rc_++) { const float* cw = as_global(p.in[25]); const float* cb = as_global(p.in[26]); const float* alog = as_global(p.in[28]);
          const int nrun = S_ / 8;
          for (int it = gt; it < nrun * 384; it += nt_all) { int cc = it % 384, run = it / 384; int ch0 = cc * 8; int t0 = run * 8;
            float hist[3][8];
#pragma unroll
            for (int d = 0; d < 3; d++) { int tt = t0 - 3 + d;
              if (tt >= 0) { U4 q = *(const U4*)(XR + (size_t)tt * 3072 + ch0);
#pragma unroll
                for (int e = 0; e < 4; e++) { hist[d][2 * e] = bf2f((bf16_t)(q[e] & 0xffff)); hist[d][2 * e + 1] = bf2f((bf16_t)(q[e] >> 16)); } }
              else {
#pragma unroll
                for (int e = 0; e < 8; e++) hist[d][e] = 0.f; } }
            float w0[8], w1[8], w2[8], w3[8], bs[8];
#pragma unroll
            for (int e = 0; e < 8; e++) { w0[e] = cw[ch0 + e]; w1[e] = cw[3072 + ch0 + e]; w2[e] = cw[2 * 3072 + ch0 + e]; w3[e] = cw[3 * 3072 + ch0 + e]; bs[e] = cb[ch0 + e]; }
            for (int i = 0; i < 8; i++) { int tt = t0 + i; U4 q = *(const U4*)(XR + (size_t)tt * 3072 + ch0); float cur[8]; unsigned ov[4];
#pragma unroll
              for (int e = 0; e < 4; e++) { cur[2 * e] = bf2f((bf16_t)(q[e] & 0xffff)); cur[2 * e + 1] = bf2f((bf16_t)(q[e] >> 16)); }
              float res[8];
#pragma unroll
              for (int e = 0; e < 8; e++) { float a = bs[e] + w0[e] * hist[0][e] + w1[e] * hist[1][e] + w2[e] * hist[2][e] + w3[e] * cur[e]; res[e] = siluf_(a); hist[0][e] = hist[1][e]; hist[1][e] = hist[2][e]; hist[2][e] = cur[e]; }
#pragma unroll
              for (int e = 0; e < 4; e++) ov[e] = pack2(res[2 * e], res[2 * e + 1]);
              U4 o; o.x = ov[0]; o.y = ov[1]; o.z = ov[2]; o.w = ov[3];
              if (ch0 < 2048) *(U4*)(XS + (size_t)tt * 2048 + ch0) = o;
              else if (ch0 < 2560) *(U4*)(BM + (size_t)tt * 512 + ch0 - 2048) = o;
              else *(U4*)(CM + (size_t)tt * 512 + ch0 - 2560) = o; }
          }
          for (int it = gw; it < (S_ / 256) * 32; it += nw) { int hh = it & 31, c = it >> 5; float A = -expf(alog[hh]);
            float d[4]; float run = 0;
#pragma unroll
            for (int e = 0; e < 4; e++) { d[e] = DT[(size_t)(c * 256 + lane * 4 + e) * 32 + hh]; }
            float pre[4];
#pragma unroll
            for (int e = 0; e < 4; e++) { run += d[e] * A; pre[e] = run; }
            float sc = run;
#pragma unroll
            for (int dd = 1; dd < 64; dd <<= 1) { float tv = __shfl_up(sc, dd); if (lane >= dd) sc += tv; }
            float excl = sc - run;
            f32x4 dv, cv;
#pragma unroll
            for (int e = 0; e < 4; e++) { dv[e] = d[e]; cv[e] = excl + pre[e]; }
            *(f32x4*)(DTH + (size_t)hh * S_ + c * 256 + lane * 4) = dv; *(f32x4*)(CUMH + (size_t)hh * S_ + c * 256 + lane * 4) = cv; }
        }
        GRID_SYNC(); rederive();
        for (int rs_ = 0; rs_ < NREP(256); rs_++) { const int NC = S_ / 256; const int nCB = NC * 4 * 4, nST = NC * 32;
          for (int it_ = 0, tile; (tile = rmap(it_)) < nCB + nST; it_++) {
            if (tile < nCB) { int ni = tile & 1, mi = (tile >> 1) & 1, g = (tile >> 2) & 3, c = tile >> 4;
              f32x4 acc[4][4]; zero_acc<4, 4>(acc);
              gemm_acc<2, 2, 4, 4, 0, 0, NoAX>(acc, CM + (size_t)(c * 256 + mi * 128) * 512 + g * 128, 512, BM + (size_t)(c * 256 + ni * 128) * 512 + g * 128, 512, 128, smem, NoAX());
              bf16_t* dst = CB + (size_t)(c * 4 + g) * 65536; int m0 = mi * 128 + (wave >> 1) * 64, n0 = ni * 128 + (wave & 1) * 64;
#pragma unroll
              for (int mt = 0; mt < 4; mt++)
#pragma unroll
                for (int nt = 0; nt < 4; nt++)
#pragma unroll
                  for (int j = 0; j < 4; j++) dst[(size_t)(m0 + mt * 16 + quad * 4 + j) * 256 + n0 + nt * 16 + c16] = f2bf(acc[mt][nt][j]);
            } else { int tl = tile - nCB; int hh = tl & 31, c = tl >> 5; int g = hh >> 3;
              const float* dth = DTH + (size_t)hh * S_ + c * 256; const float* cmh = CUMH + (size_t)hh * S_ + c * 256; float cend = cmh[255];
              AXst ax{dth, cmh, cend};
              f32x4 acc[2][4]; zero_acc<2, 4>(acc);
              gemm_acc<2, 2, 2, 4, 1, 1, AXst>(acc, XS + (size_t)(c * 256) * 2048 + hh * 64, 2048, BM + (size_t)(c * 256) * 512 + g * 128, 512, 256, smem, ax);
              bf16_t* dst = ST + (size_t)(c * 32 + hh) * 8192; int m0 = (wave >> 1) * 32, n0 = (wave & 1) * 64;
#pragma unroll
              for (int mt = 0; mt < 2; mt++)
#pragma unroll
                for (int nt = 0; nt < 4; nt++)
#pragma unroll
                  for (int j = 0; j < 4; j++) dst[(size_t)(m0 + mt * 16 + quad * 4 + j) * 128 + n0 + nt * 16 + c16] = f2bf(acc[mt][nt][j]);
            }
          } }
        GRID_SYNC(); rederive();
        { const int NC = S_ / 256;
          constexpr int UB = (S_ / 256) % 8 == 0 ? 8 : 2;
          for (int e = gt; e < 32 * 8192; e += nt_all) { int hh = e >> 13; float run = 0;
            for (int c0 = 0; c0 < NC; c0 += UB) { float cv[UB], ce[UB];
#pragma unroll
              for (int u = 0; u < UB; u++) { cv[u] = bf2f(ST[(size_t)(c0 + u) * 32 * 8192 + e]); ce[u] = CUMH[(size_t)hh * S_ + (c0 + u) * 256 + 255]; }
#pragma unroll
              for (int u = 0; u < UB; u++) { ST[(size_t)(c0 + u) * 32 * 8192 + e] = f2bf(run); run = run * __expf(ce[u]) + cv[u]; } } } }
        GRID_SYNC(); rederive();
        for (int ry_ = NREP(4096) - 1; ry_ >= 0; ry_--) { const int NC = S_ / 256; const float* dsk = as_global(p.in[29]); bf16_t* YD = ry_ ? XR : Z;
          U4 ya1[4], yb1[2], ya2[4], yb2[2];
          auto p1A = [&](int tl) { int mi = tl & 1, hh = (tl >> 1) & 31, c = tl >> 6; return CM + (size_t)(c * 256 + mi * 128) * 512 + (hh >> 3) * 128; };
          auto p1B = [&](int tl) { int hh = (tl >> 1) & 31, c = tl >> 6; return ST + (size_t)(c * 32 + hh) * 8192; };
          if (rmap(0) < NC * 32 * 2) gemm_preload<128, 64, 0, 0>(ya1, yb1, p1A(rmap(0)), 512, p1B(rmap(0)), 128);
          for (int it_ = 0, tile; (tile = rmap(it_)) < NC * 32 * 2; it_++) { int mi = tile & 1, hh = (tile >> 1) & 31, c = tile >> 6; int g = hh >> 3;
            const float* dth = DTH + (size_t)hh * S_ + c * 256; const float* cmh = CUMH + (size_t)hh * S_ + c * 256;
            const bf16_t* A2 = CB + (size_t)(c * 4 + g) * 65536 + (size_t)(mi * 128) * 256; const bf16_t* B2 = XS + (size_t)(c * 256) * 2048 + hh * 64;
            gemm_preload<128, 64, 0, 1>(ya2, yb2, A2, 256, B2, 2048);
            f32x4 acc[4][2]; zero_acc<4, 2>(acc);
            gemm_acc_pre<2, 2, 4, 2, 0, 0, NoAX>(acc, ya1, yb1, p1A(tile), 512, p1B(tile), 128, 128, smem, NoAX());
            int m0 = mi * 128 + (wave >> 1) * 64, n0 = (wave & 1) * 32;
#pragma unroll
            for (int mt = 0; mt < 4; mt++)
#pragma unroll
              for (int j = 0; j < 4; j++) { float e = __expf(cmh[m0 + mt * 16 + quad * 4 + j]); acc[mt][0][j] *= e; acc[mt][1][j] *= e; }
            AXy ax{dth, cmh, mi * 128};
            gemm_acc_pre<2, 2, 4, 2, 0, 1, AXy>(acc, ya2, yb2, A2, 256, B2, 2048, (mi + 1) * 128, smem, ax);
            if (rmap(it_ + 1) < NC * 32 * 2) gemm_preload<128, 64, 0, 0>(ya1, yb1, p1A(rmap(it_ + 1)), 512, p1B(rmap(it_ + 1)), 128);
            float dv = dsk[hh];
#pragma unroll
            for (int mt = 0; mt < 4; mt++)
#pragma unroll
              for (int nt = 0; nt < 2; nt++)
#pragma unroll
                for (int j = 0; j < 4; j++) { size_t o = (size_t)(c * 256 + m0 + mt * 16 + quad * 4 + j) * 2048 + hh * 64 + n0 + nt * 16 + c16;
                  float y = acc[mt][nt][j] + dv * bf2f(XS[o]); y *= siluf_(bf2f(Z[o])); YD[o] = f2bf(y); }
          } }
        GRID_SYNC(); rederive();
        for (int rg_ = NREP(4096) - 1; rg_ >= 0; rg_--) { const float* gn = as_global(p.in[30]); bf16_t* YD = rg_ ? XR : Z;
          for (int it = gw; it < S_ * 4; it += nw) { size_t r = it >> 2; int g = it & 3; bf16_t* yp = Z + r * 2048 + g * 512 + lane * 8;
            U4 q = *(const U4*)yp; float v[8]; float ss = 0;
#pragma unroll
            for (int e = 0; e < 4; e++) { v[2 * e] = bf2f((bf16_t)(q[e] & 0xffff)); v[2 * e + 1] = bf2f((bf16_t)(q[e] >> 16)); }
#pragma unroll
            for (int e = 0; e < 8; e++) ss += v[e] * v[e];
            ss = wave_sum(ss); float rs = rsqrtf(ss * (1.0f / 512.0f) + EPS); const float* gg = gn + g * 512 + lane * 8;
#pragma unroll
            for (int e = 0; e < 4; e++) q[e] = pack2(v[2 * e] * rs * gg[2 * e], v[2 * e + 1] * rs * gg[2 * e + 1]);
            *(U4*)(YD + r * 2048 + g * 512 + lane * 8) = q; } }
        GRID_SYNC(); rederive();
        { float* hb = hbuf + (size_t)bb * S_ * 1024;
          if ((REP) & 2048) gemm_resid(Z, 2048, WB(W_ODOUT), S_, 2048, hb, (float*)(ws + O_XR), smem, bid, nblk);
          gemm_resid(Z, 2048, WB(W_ODOUT), S_, 2048, hb, hb, smem, bid, nblk); }
        GRID_SYNC(); rederive();
      }
    }
    for (int r_ = 0; r_ < NREP(32); r_++) rmsnorm_rows(hbuf, as_global(p.in[32]) + layer * 1024, WB(X_AN), T_, gw, nw);
    if (layer == 0) {
      convert_weight(as_global(p.in[24]), WB(W_ODIN), 1024, ODIN, ODIN_P, false, smem, bid, nblk);
      convert_weight(as_global(p.in[31]), WB(W_ODOUT), 2048, 1024, 1024, false, smem, bid, nblk);
      convert_weight(as_global(p.in[34]) + (size_t)1024 * 512, WB(W_XQ1), 1024, 512, 512, false, smem, bid, nblk);
      convert_weight(as_global(p.in[38]) + (size_t)512 * 1024, WB(W_XO1), 512, 1024, 1024, false, smem, bid, nblk);
      convert_weight(as_global(p.in[40]) + (size_t)1024 * 2 * FH, WB(W_F13_1), 1024, 2 * FH, 2 * FH, true, smem, bid, nblk);
      convert_weight(as_global(p.in[41]) + (size_t)FH * 1024, WB(W_F2_1), FH, 1024, 1024, false, smem, bid, nblk);
    }
    GRID_SYNC(); rederive();
    for (int rq_ = 0; rq_ < NREP(512); rq_++) {
      const bf16_t* Wq = WB(layer ? W_XQ1 : W_XQ0); const float* qh = as_global(p.in[36]) + layer * 128; bf16_t* QX = WB(X_QX);
      for (int it_ = 0, tile; (tile = rmap(it_)) < (T_ / 128) * 4; it_++) { int hh = tile & 3, tm = tile >> 2;
        f32x4 acc[2][8]; zero_acc<2, 8>(acc);
        gemm_acc<4, 1, 2, 8, 0, 0, NoAX>(acc, WB(X_AN) + (size_t)tm * 128 * 1024, 1024, Wq + (size_t)hh * 128 * 1024, 1024, 1024, smem, NoAX());
#pragma unroll
        for (int mt = 0; mt < 2; mt++)
#pragma unroll
          for (int j = 0; j < 4; j++) { size_t t = (size_t)(tm * 128 + wave * 32 + mt * 16 + quad * 4 + j); float ss = 0;
#pragma unroll
            for (int nt = 0; nt < 8; nt++) ss += acc[mt][nt][j] * acc[mt][nt][j];
            ss = sum16(ss); float rs = rsqrtf(ss * (1.0f / 128.0f) + EPS) * (0.08838834764831845f * 1.4426950408889634f);
#pragma unroll
            for (int nt = 0; nt < 8; nt++) QX[t * 512 + hh * 128 + nt * 16 + c16] = f2bf(acc[mt][nt][j] * rs * qh[nt * 16 + c16]); }
      } }
    GRID_SYNC(); rederive();
    for (int ra_ = 0; ra_ < NREP(512); ra_++) { const int nqb = S_ / 64;
      for (int it_ = 0, item; (item = rmap(it_)) < NB * 4 * nqb; it_++) { int qb = item % nqb; int bh = item / nqb; int bb = bh >> 2, hh = bh & 3;
        attn_item<128, 128, false, 1>(WB(X_QX) + (size_t)bb * S_ * 512 + hh * 128, 512, WB(M_KX) + (((size_t)layer * NB + bb) * 4 + hh) * 256 * 128, 128,
                                   WB(M_VXT) + (((size_t)layer * NB + bb) * 4 + hh) * 128 * 256, 256, WB(X_AXO) + (size_t)bb * S_ * 512 + hh * 128, 512, qb * 64, 256, smem); } }
    GRID_SYNC(); rederive();
    if ((REP) & 2048) gemm_resid(WB(X_AXO), 512, WB(layer ? W_XO1 : W_XO0), T_, 512, hbuf, (float*)(ws + X_END), smem, bid, nblk);
    gemm_resid(WB(X_AXO), 512, WB(layer ? W_XO1 : W_XO0), T_, 512, hbuf, hbuf, smem, bid, nblk);
    GRID_SYNC(); rederive();
    for (int r_ = 0; r_ < NREP(32); r_++) rmsnorm_rows(hbuf, as_global(p.in[39]) + layer * 1024, WB(X_AN), T_, gw, nw);
    GRID_SYNC(); rederive();
    for (int rep_ = 0; rep_ < NREP(1); rep_++) { bf16_t* HID = WB(X_HID);
      gemm_phase_128(WB(X_AN), 1024, WB(layer ? W_F13_1 : W_F13_0), T_, 2 * FH, 1024, smem, bid, nblk, [&](f32x4 (&acc)[4][4], int m0, int n0) {
        int hc0 = n0 >> 1;
#pragma unroll
        for (int mt = 0; mt < 4; mt++)
#pragma unroll
          for (int nt = 0; nt < 2; nt++)
#pragma unroll
            for (int j = 0; j < 4; j++) HID[(size_t)(m0 + mt * 16 + quad * 4 + j) * FH + hc0 + nt * 16 + c16] = f2bf(siluf_(acc[mt][nt][j]) * acc[mt][nt + 2][j]);
      }); }
    GRID_SYNC(); rederive();
    if ((REP) & 2048) gemm_resid(WB(X_HID), FH, WB(layer ? W_F2_1 : W_F2_0), T_, FH, hbuf, (float*)(ws + X_END), smem, bid, nblk);
    gemm_resid(WB(X_HID), FH, WB(layer ? W_F2_1 : W_F2_0), T_, FH, hbuf, hbuf, smem, bid, nblk);
    GRID_SYNC(); rederive();
  }
}

extern "C" void kernel_launch(void* const* d_in, const int* in_sizes, int n_in, void* d_out, int out_size, void* d_ws, size_t ws_size, hipStream_t stream) {
  Params p{};
  for (int i = 0; i < 42; i++) p.in[i] = (const GAS float*)d_in[i];
  p.out = (GAS float*)d_out; p.ws = (GAS char*)d_ws;
#ifndef EMU
  static int grid_blocks = 0;
  if (!grid_blocks) {
    int dev = 0, cus = 0, per_cu = 0;
    hipGetDevice(&dev);
    hipDeviceGetAttribute(&cus, hipDeviceAttributeMultiprocessorCount, dev);
    hipFuncSetAttribute((const void*)fwd_megakernel, hipFuncAttributeMaxDynamicSharedMemorySize, SMEM_BYTES);
    hipOccupancyMaxActiveBlocksPerMultiprocessor(&per_cu, fwd_megakernel, NTHR, SMEM_BYTES);
    if (per_cu > 2) per_cu = 2;
    if (per_cu < 1) per_cu = 1;
    grid_blocks = cus * per_cu;
  }
  void* args[] = {&p};
  hipError_t e = hipLaunchCooperativeKernel((const void*)fwd_megakernel, dim3(grid_blocks), dim3(NTHR), args, SMEM_BYTES, stream);
  if (e != hipSuccess) fprintf(stderr, "cooperative launch failed: %s (grid %d)\n", hipGetErrorString(e), grid_blocks);
#else
  emu_launch([&]() { fwd_megakernel(p); }, EMU_GRID, NTHR, SMEM_BYTES);
#endif
}
```
